# Optimizing an MI355X kernel written in HIP

```python
import math
import jax, jax.numpy as jnp
from jax import lax
import numpy as np

D_MODEL = 1024
BATCH = 32
SEQ = 2048
DEPTH = 4

GRID_W = 64
CTX_LEN = 256
N_MOD = 6
ATTN_HEADS = 4
ATTN_QK_DIM = 64
ATTN_V_DIM = 2 * ATTN_QK_DIM
Q_COLS = ATTN_HEADS * 2 * ATTN_QK_DIM
K_COLS = Q_COLS
V_COLS = ATTN_HEADS * ATTN_V_DIM
ATTN_SCALE = ATTN_QK_DIM ** -0.5
ROPE_THETA = 10000.0
BLOCK_Q = 128
CONV_WIDTH = D_MODEL // 4
POOL_WINDOWS = (2, 4, 8, 16)
POOL_GROUPS = len(POOL_WINDOWS)
POOL_WIDTH = D_MODEL - V_COLS - CONV_WIDTH
POOL_GROUP_DIM = POOL_WIDTH // POOL_GROUPS
Q_END = Q_COLS
K_END = Q_END + K_COLS
V_END = K_END + V_COLS
CONV_END = V_END + 3 * CONV_WIDTH
IN_COLS = CONV_END + POOL_WIDTH
MIX_WIDTH = V_COLS + CONV_WIDTH + POOL_WIDTH
FFN_HIDDEN = -(-(8 * D_MODEL) // (3 * 256)) * 256
EPS = 1e-6

kernel_name = "hybrid_diff_conv_pool_dit"


def rms_norm(x, g):
    xf = x.astype(jnp.float32)
    y = xf * lax.rsqrt(jnp.mean(xf * xf, axis=-1, keepdims=True) + EPS)
    return y.astype(x.dtype) * g


def modulate(h, shift, scale):
    return h * (1.0 + scale) + shift


def axial_rope_tables(length, dtype):
    rows = length // GRID_W
    row = jnp.broadcast_to(jnp.arange(rows)[:, None], (rows, GRID_W)).reshape(-1).astype(jnp.float32)
    col = jnp.broadcast_to(jnp.arange(GRID_W)[None, :], (rows, GRID_W)).reshape(-1).astype(jnp.float32)
    nf = ATTN_QK_DIM // 4
    inv = 1.0 / (ROPE_THETA ** (jnp.arange(nf, dtype=jnp.float32) / nf))
    ang_r = row[:, None] * inv[None, :]
    ang_c = col[:, None] * inv[None, :]
    ang = jnp.concatenate([ang_r, ang_r, ang_c, ang_c], axis=-1)
    return jnp.cos(ang).astype(dtype), jnp.sin(ang).astype(dtype)


def apply_rope(t, cos, sin):
    nf = ATTN_QK_DIM // 4
    tr = t.reshape(t.shape[:-1] + (2, 2, nf))
    rot = jnp.stack([-tr[..., 1, :], tr[..., 0, :]], axis=-2).reshape(t.shape)
    return t * cos + rot * sin


def split_heads_qk(t):
    b, l, _ = t.shape
    return t.reshape(b, l, ATTN_HEADS, 2, ATTN_QK_DIM).transpose(0, 2, 3, 1, 4)


def split_heads_v(t):
    b, l, _ = t.shape
    return t.reshape(b, l, ATTN_HEADS, ATTN_V_DIM).transpose(0, 2, 1, 3)


def diff_attention_core(q, k, v, lam):
    s = jnp.einsum('bhcqd,bhckd->bhcqk', q, k).astype(jnp.float32) * ATTN_SCALE
    p = jax.nn.softmax(s, axis=-1)
    a = p[:, :, 0] - lam * p[:, :, 1]
    return jnp.einsum('bhqk,bhkd->bhqd', a.astype(v.dtype), v)


def diff_attn_post(o, g_sub, lam_init):
    o = rms_norm(o, g_sub) * (1.0 - lam_init)
    b, h, l, dv = o.shape
    return o.transpose(0, 2, 1, 3).reshape(b, l, h * dv)


def conv_mixer(bcx, w_conv):
    bg, cg, xin = jnp.split(bcx, 3, axis=-1)
    u = cg * xin
    up = jnp.pad(u, ((0, 0), (1, 1), (0, 0)))
    y = up[:, :-2] * w_conv[0] + up[:, 1:-1] * w_conv[1] + up[:, 2:] * w_conv[2]
    return bg * y


def pool_mixer(p, w_pool, s_pool):
    b, l, _ = p.shape
    pf = p.astype(jnp.float32)
    cs = jnp.concatenate([jnp.zeros((b, 1, POOL_WIDTH), jnp.float32), jnp.cumsum(pf, axis=1)], axis=1)
    cs = cs.reshape(b, l + 1, POOL_GROUPS, POOL_GROUP_DIM)
    t = jnp.arange(l)[:, None]
    win = jnp.array(POOL_WINDOWS, dtype=jnp.int32)[None, :]
    lo = jnp.clip(t - win // 2, 0, l - 1)
    hi = jnp.clip(t + win - 1 - win // 2, 0, l - 1)
    grp = jnp.arange(POOL_GROUPS)[None, :]
    cnt = (hi - lo + 1).astype(jnp.float32)[None, :, :, None]
    mean = (cs[:, hi + 1, grp, :] - cs[:, lo, grp, :]) / cnt
    pooled = (mean - pf.reshape(b, l, POOL_GROUPS, POOL_GROUP_DIM)).astype(p.dtype)
    y = jnp.einsum('blgc,gcd->blgd', pooled, w_pool).reshape(b, l, POOL_WIDTH)
    return y * s_pool


def swiglu(h, w_gate_up, w_down):
    g, u = jnp.split(h @ w_gate_up, 2, axis=-1)
    return (jax.nn.silu(g) * u) @ w_down


def setup_inputs(seed: int = 0) -> dict:
    key = jax.random.key(seed)
    ks = jax.random.split(key, 24)
    f32 = jnp.float32
    D = D_MODEL

    def nrm(k, shape, scale):
        return jax.random.normal(k, shape, f32) * scale

    return {
        'x': nrm(ks[0], (BATCH, SEQ, D), 1.0),
        'c': nrm(ks[1], (BATCH, D), 1.0),
        'ctx': nrm(ks[2], (BATCH, CTX_LEN, D), 1.0),
        'c_ctx': nrm(ks[3], (D,), 1.0),
        'w_ada': nrm(ks[4], (DEPTH, D, N_MOD * D), 0.5 * D ** -0.5),
        'b_ada': nrm(ks[5], (DEPTH, N_MOD * D), 0.02),
        'g_norm1': 1.0 + nrm(ks[6], (DEPTH, D), 0.05),
        'w_in': nrm(ks[7], (DEPTH, D, IN_COLS), D ** -0.5),
        'lam_q1': nrm(ks[8], (DEPTH, ATTN_QK_DIM), 0.1),
        'lam_k1': nrm(ks[9], (DEPTH, ATTN_QK_DIM), 0.1),
        'lam_q2': nrm(ks[10], (DEPTH, ATTN_QK_DIM), 0.1),
        'lam_k2': nrm(ks[11], (DEPTH, ATTN_QK_DIM), 0.1),
        'g_subln': 1.0 + nrm(ks[12], (DEPTH, ATTN_V_DIM), 0.05),
        'w_conv': nrm(ks[13], (DEPTH, 3, CONV_WIDTH), 3 ** -0.5),
        'w_pool': nrm(ks[14], (DEPTH, POOL_GROUPS, POOL_GROUP_DIM, POOL_GROUP_DIM), POOL_GROUP_DIM ** -0.5),
        's_pool': 1.0 + nrm(ks[15], (DEPTH, POOL_WIDTH), 0.1),
        'w_out': nrm(ks[16], (DEPTH, MIX_WIDTH, D), MIX_WIDTH ** -0.5),
        'g_norm2': 1.0 + nrm(ks[17], (DEPTH, D), 0.05),
        'w_gate_up': nrm(ks[18], (DEPTH, D, 2 * FFN_HIDDEN), D ** -0.5),
        'w_down': nrm(ks[19], (DEPTH, FFN_HIDDEN, D), FFN_HIDDEN ** -0.5),
        'g_final': 1.0 + nrm(ks[20], (D,), 0.05),
    }


def reference(x, c, ctx, c_ctx, w_ada, b_ada, g_norm1, w_in, lam_q1, lam_k1, lam_q2, lam_k2,
              g_subln, w_conv, w_pool, s_pool, w_out, g_norm2, w_gate_up, w_down, g_final):
    b, seq_len, _ = x.shape
    n_blocks = seq_len // BLOCK_Q
    cos, sin = axial_rope_tables(seq_len, x.dtype)
    s_lat = jax.nn.silu(c)
    s_ctx = jax.nn.silu(c_ctx)
    x_lat, x_ctx = x, ctx
    for l in range(DEPTH):
        last = l == DEPTH - 1
        lam_init = 0.8 - 0.6 * math.exp(-0.3 * l)
        lam = (jnp.exp(jnp.sum(lam_q1[l] * lam_k1[l]).astype(jnp.float32))
               - jnp.exp(jnp.sum(lam_q2[l] * lam_k2[l]).astype(jnp.float32)) + lam_init)

        mod = s_lat @ w_ada[l] + b_ada[l]
        sh1, sc1, gt1, sh2, sc2, gt2 = jnp.split(mod[:, None, :], N_MOD, axis=-1)
        n_ctx_mod = 2 if last else N_MOD
        mod_c = s_ctx @ w_ada[l][:, :n_ctx_mod * D_MODEL] + b_ada[l][:n_ctx_mod * D_MODEL]
        mods_c = jnp.split(mod_c, n_ctx_mod)

        h = modulate(rms_norm(x_lat, g_norm1[l]), sh1, sc1)
        hc = modulate(rms_norm(x_ctx, g_norm1[l]), mods_c[0], mods_c[1])

        proj = h @ w_in[l]
        kv_c = hc @ w_in[l][:, Q_END:V_END]
        k_c = split_heads_qk(kv_c[..., :K_COLS])
        v_c = split_heads_v(kv_c[..., K_COLS:])

        q_l = apply_rope(split_heads_qk(proj[..., :Q_END]), cos, sin)
        k_l = apply_rope(split_heads_qk(proj[..., Q_END:K_END]), cos, sin)
        v_l = split_heads_v(proj[..., K_END:V_END])
        k_all = jnp.concatenate([k_c, k_l], axis=3)
        v_all = jnp.concatenate([v_c, v_l], axis=2)
        qb = jnp.moveaxis(q_l.reshape(b, ATTN_HEADS, 2, n_blocks, BLOCK_Q, ATTN_QK_DIM), 3, 0)
        o_l = lax.map(lambda qi: diff_attention_core(qi, k_all, v_all, lam), qb)
        o_l = jnp.moveaxis(o_l, 0, 2).reshape(b, ATTN_HEADS, seq_len, ATTN_V_DIM)

        mix = jnp.concatenate([
            diff_attn_post(o_l, g_subln[l], lam_init),
            conv_mixer(proj[..., V_END:CONV_END], w_conv[l]),
            pool_mixer(proj[..., CONV_END:], w_pool[l], s_pool[l]),
        ], axis=-1) @ w_out[l]
        x_lat = x_lat + gt1 * mix
        h2 = modulate(rms_norm(x_lat, g_norm2[l]), sh2, sc2)
        x_lat = x_lat + gt2 * swiglu(h2, w_gate_up[l], w_down[l])

        if not last:
            q_c = split_heads_qk(hc @ w_in[l][:, :Q_END])
            rest_c = hc @ w_in[l][:, V_END:]
            o_c = diff_attention_core(q_c, k_c, v_c, lam)
            mix_c = jnp.concatenate([
                diff_attn_post(o_c, g_subln[l], lam_init),
                conv_mixer(rest_c[..., :3 * CONV_WIDTH], w_conv[l]),
                pool_mixer(rest_c[..., 3 * CONV_WIDTH:], w_pool[l], s_pool[l]),
            ], axis=-1) @ w_out[l]
            x_ctx = x_ctx + mods_c[2] * mix_c
            h2c = modulate(rms_norm(x_ctx, g_norm2[l]), mods_c[3], mods_c[4])
            x_ctx = x_ctx + mods_c[5] * swiglu(h2c, w_gate_up[l], w_down[l])
    return rms_norm(x_lat, g_final)
```

```cpp
#include <hip/hip_runtime.h>
#include <hip/hip_cooperative_groups.h>
#include <cstdio>
#include <cstdint>
namespace cg = cooperative_groups;

#define LAS __attribute__((address_space(3)))
typedef unsigned short bf16_t;
typedef short bf16x8 __attribute__((ext_vector_type(8)));
typedef short s16x4 __attribute__((ext_vector_type(4)));
typedef float f32x4 __attribute__((ext_vector_type(4)));
typedef float f32x16 __attribute__((ext_vector_type(16)));
typedef unsigned u32x4 __attribute__((ext_vector_type(4)));
typedef unsigned u32x2 __attribute__((ext_vector_type(2)));

constexpr int DM = 1024, NB = 32, SEQ = 2048, DEPTH = 4, CTXL = 256;
constexpr int MLAT = NB * SEQ, MCTX = NB * CTXL, MALL = MLAT + MCTX;
constexpr int INC = 2560, FFN = 2816, NMOD = 6;
constexpr float EPS = 1e-6f;
constexpr int NTHREADS = 512;
constexpr int LDS_BYTES = 152 * 1024;

constexpr size_t WS_XB   = 0;
constexpr size_t WS_ACT  = WS_XB + (size_t)MALL * DM * 2;
constexpr size_t WS_PROJ = WS_ACT + (size_t)MALL * DM * 2;
constexpr size_t WS_W    = WS_PROJ + (size_t)MALL * FFN * 2;
constexpr size_t W_IN_E = (size_t)INC * DM, W_OUT_E = (size_t)DM * DM, W_GU_E = (size_t)2 * FFN * DM, W_DN_E = (size_t)DM * FFN;
constexpr size_t W_LAYER_E = W_IN_E + W_OUT_E + W_GU_E + W_DN_E;
constexpr size_t WS_WPOOL = WS_W + W_LAYER_E * 2 * DEPTH;
constexpr size_t WS_MOD  = WS_WPOOL + (size_t)DEPTH * 4 * 64 * 64 * 2;
constexpr size_t WS_ROPE = WS_MOD + (size_t)DEPTH * 33 * NMOD * DM * 4;
constexpr size_t WS_LAM  = WS_ROPE + 2 * 64 * 16 * 4;
constexpr size_t WS_BAR  = WS_LAM + 256;
constexpr size_t WS_H2   = WS_BAR + 256;
constexpr int    NFUSE   = 2 * DEPTH;
constexpr size_t WS_XCH  = WS_H2 + (size_t)MALL * DM * 2;
constexpr size_t WS_CNT  = WS_XCH + (size_t)NFUSE * MALL * 4 * 4;
constexpr size_t WS_SLAB = WS_CNT + (size_t)NFUSE * (MALL / 256) * 256;
constexpr size_t WS_SKC  = WS_SLAB + (size_t)128 * 256 * 1024;
constexpr size_t WS_END  = WS_SKC + (size_t)2 * DEPTH * 128 * 256;

#ifndef ONLY
#define ONLY -1
#endif
#define EN(n) (ONLY < 0 || ONLY == (n))
#ifndef DUP
#define DUP 0
#endif
struct Params { const float* in[21]; float* out; unsigned char* ws; };

__device__ __forceinline__ int opaque_tid() { int t = threadIdx.x; asm volatile("" : "+v"(t)); return t; }
__device__ __forceinline__ float bperm_xor(float v, int m, int lane) { return __builtin_bit_cast(float, __builtin_amdgcn_ds_bpermute((lane ^ m) << 2, __builtin_bit_cast(int, v))); }
__device__ __forceinline__ float local_const(unsigned bits) { float f; asm volatile("v_mov_b32 %0, %1" : "=v"(f) : "s"(bits)); return f; }
__device__ __forceinline__ unsigned cvt_pk_bf16(float lo, float hi) { unsigned r; asm volatile("v_cvt_pk_bf16_f32 %0, %1, %2" : "=v"(r) : "v"(lo), "v"(hi)); return r; }

namespace pg8 {
constexpr int BM = 256, BK = 64, HALF = 128, HTB = HALF * BK * 2, STAGE_BYTES = 8 * HTB;
__device__ __forceinline__ int lds_byte(int r, int c) { const int st = (r >> 4) * 2 + (c >> 5), rr = r & 15, cc = c & 31, ob = rr * 64 + cc * 2; return st * 1024 + (ob ^ (((ob >> 9) & 1) << 5)); }
__device__ __forceinline__ void stage_rc(int b, int& R, int& C) { const int st = b / 1024, sb = b % 1024, swz = sb ^ (((sb >> 9) & 1) << 5); R = (st >> 1) * 16 + swz / 64; C = (st & 1) * 32 + (swz % 64) / 2; }
__device__ __forceinline__ int perm32(int rho) { const int n = rho >> 4, i = rho & 15; return 8 * (i >> 2) + 4 * n + (i & 3); }
struct Unit { int pm, pn, kt0, nkt, role, ui; };
struct Gemm { const bf16_t* A; const bf16_t* Bt; int K; };

__device__ __forceinline__ int divn(int x, int d) { const unsigned ux = (unsigned)x; return (int)(d == 4 ? (ux >> 2) : (d == 10 ? ux / 10u : ux / 22u)); }
struct Sched {
    int nN, nLat, nTot, G, c, cpn0, cnN, nkt, nCtx; bool split;
    __device__ void init(int nN_, int nCtxRows, int cpn0_, int cnN_, int G_, int c_, int nkt_, bool split_ = false) { nN = nN_; nLat = 256 * nN_; cpn0 = cpn0_; cnN = cnN_; nCtx = nCtxRows * cnN_; split = split_ && nCtx > 0;
        nTot = nLat + (split ? 2 : 1) * nCtx; G = G_; c = c_; nkt = nkt_; }
    __device__ __forceinline__ bool next(int i, Unit& u) const {
        const int L = i * G + c; if (L >= nTot) return false;
        u.kt0 = 0; u.nkt = nkt; u.role = 0; u.ui = 0;
        if (L < nLat) {
            const int q = nLat >> 3; const int wgid = (L & 7) * q + (L >> 3);
            const int gid = divn(wgid >> 3, nN), rem = wgid - gid * 8 * nN;
            u.pm = gid * 8 + (rem & 7); u.pn = rem >> 3;
        } else { int Lc = L - nLat;
            if (split) { u.nkt = nkt >> 1; if (Lc >= nCtx) { Lc -= nCtx; u.role = 2; u.kt0 = nkt >> 1; } else u.role = 1; u.ui = Lc; }
            const int qd = divn(Lc, cnN); u.pm = 256 + qd; u.pn = cpn0 + (Lc - qd * cnN); }
        return true;
    }
};

template <class Epi>
__device__ __forceinline__ void gemm_phase(LAS unsigned char* lds, const Gemm g, const Sched& S, const Epi& E) {
    const int tid = opaque_tid(), wid = __builtin_amdgcn_readfirstlane(tid >> 6), lane = tid & 63, wr = wid >> 2, wc = wid & 3, fr = lane & 15, fq = lane >> 4;
    const int K = g.K;
    unsigned voffA[2], voffB[2];
#pragma unroll
    for (int i = 0; i < 2; ++i) { int R, C; stage_rc(tid * 16 + i * 8192, R, C); const int Rb = Epi::PERM ? ((R & ~31) + perm32(R & 31)) : R;
        voffA[i] = (unsigned)(R * K + C) * 2u; voffB[i] = (unsigned)(Rb * K + C) * 2u; }
    const size_t kstep = (size_t)(BK * 2);
    const size_t hstep = (size_t)HALF * K * 2;
    const size_t tstep = 2 * hstep;
    const unsigned ldsw = (unsigned)wid * 1024u;
    const int aoff = lds_byte(wr * 64 + fr, fq * 8), boff = lds_byte(wc * 32 + fr, fq * 8);
#define PG8_SA(b, h) (((b) * 2 + (h)) * HTB)
#define PG8_SB(b, h) ((4 + (b) * 2 + (h)) * HTB)
#define PG8_STAGE(bufoff, gbase, voff) do { _Pragma("unroll") for (int _i = 0; _i < 2; ++_i) \
        __builtin_amdgcn_global_load_lds((const unsigned*)((const char*)(gbase) + (voff)[_i]), (LAS unsigned*)(lds + (bufoff) + ldsw + _i * 8192), 16, 0, 0); } while (0)
#define PG8_LDA(dst, b, h) do { _Pragma("unroll") for (int m = 0; m < 4; ++m) _Pragma("unroll") for (int k = 0; k < 2; ++k) dst[m][k] = *(const LAS bf16x8*)(lds + PG8_SA(b, h) + aoff + m * 2048 + k * 1024); } while (0)
#define PG8_LDB(dst, b, h) do { _Pragma("unroll") for (int n = 0; n < 2; ++n) _Pragma("unroll") for (int k = 0; k < 2; ++k) dst[n][k] = *(const LAS bf16x8*)(lds + PG8_SB(b, h) + boff + n * 2048 + k * 1024); } while (0)
#define PG8_MMA(ai, bj, At, Bt) do { __builtin_amdgcn_s_setprio(1); _Pragma("unroll") for (int m = 0; m < 4; ++m) _Pragma("unroll") for (int n = 0; n < 2; ++n) _Pragma("unroll") for (int k = 0; k < 2; ++k) \
        acc[ai][bj][m][n] = __builtin_amdgcn_mfma_f32_16x16x32_bf16(Bt[n][k], At[m][k], acc[ai][bj][m][n], 0, 0, 0); __builtin_amdgcn_s_setprio(0); } while (0)
#define PG8_WAIT_V(n) asm volatile("s_waitcnt vmcnt(" #n ")" ::: "memory")
#define PG8_WAIT_L(n) asm volatile("s_waitcnt lgkmcnt(" #n ")" ::: "memory")
#define PG8_BAR __builtin_amdgcn_s_barrier()
#define PG8_SCHED __builtin_amdgcn_sched_barrier(0)
    Unit cur, nxt; int ui = 0;
    if (!S.next(0, cur)) return;
    f32x4 acc[2][2][4][2];
#pragma unroll
    for (int a = 0; a < 2; ++a)
#pragma unroll
        for (int b = 0; b < 2; ++b)
#pragma unroll
            for (int m = 0; m < 4; ++m)
#pragma unroll
                for (int n = 0; n < 2; ++n) acc[a][b][m][n] = (f32x4){0.f, 0.f, 0.f, 0.f};
    bf16x8 At[4][2], B0[2][2], B1[2][2];
    const char* cA = (const char*)g.A + (size_t)cur.pm * tstep + (size_t)cur.kt0 * kstep; const char* cB = (const char*)g.Bt + (size_t)cur.pn * tstep + (size_t)cur.kt0 * kstep;
    PG8_STAGE(PG8_SB(0, 0), cB, voffB); PG8_STAGE(PG8_SB(0, 1), cB + hstep, voffB); PG8_STAGE(PG8_SA(0, 0), cA, voffA); PG8_STAGE(PG8_SA(0, 1), cA + hstep, voffA);
    if (wr == 1) PG8_BAR;
    PG8_WAIT_V(2); PG8_BAR;
    PG8_STAGE(PG8_SB(1, 0), cB + kstep, voffB); PG8_STAGE(PG8_SA(1, 0), cA + kstep, voffA); PG8_STAGE(PG8_SB(1, 1), cB + hstep + kstep, voffB);
    PG8_WAIT_V(6); PG8_BAR;
    for (;;) {
        const bool has_next = S.next(ui + 1, nxt);
        const char* nA = has_next ? (const char*)g.A + (size_t)nxt.pm * tstep + (size_t)nxt.kt0 * kstep : cA; const char* nB = has_next ? (const char*)g.Bt + (size_t)nxt.pn * tstep + (size_t)nxt.kt0 * kstep : cB;
        const int nt = cur.nkt;
        for (int t = 0; t < nt; t += 2) {
            const bool last = (t == nt - 2);
            const char* a1 = cA + (size_t)(t + 1) * kstep;
            const char* a2 = last ? nA : cA + (size_t)(t + 2) * kstep; const char* b2 = last ? nB : cB + (size_t)(t + 2) * kstep;
            const char* a3 = a2 + kstep; const char* b3 = b2 + kstep;
            PG8_LDB(B0, 0, 0); PG8_LDB(B1, 0, 1); PG8_SCHED; PG8_LDA(At, 0, 0); PG8_STAGE(PG8_SA(1, 1), a1 + hstep, voffA);
            PG8_WAIT_V(8); PG8_WAIT_L(0); PG8_BAR; PG8_MMA(0, 0, At, B0); PG8_MMA(0, 1, At, B1); PG8_BAR; PG8_SCHED;
            PG8_LDA(At, 0, 1); PG8_STAGE(PG8_SB(0, 0), b2, voffB); PG8_STAGE(PG8_SB(0, 1), b2 + hstep, voffB); PG8_STAGE(PG8_SA(0, 0), a2, voffA);
            PG8_WAIT_V(8); PG8_WAIT_L(0); PG8_BAR; PG8_MMA(1, 0, At, B0); PG8_MMA(1, 1, At, B1); PG8_BAR; PG8_SCHED;
            PG8_LDB(B0, 1, 0); PG8_LDB(B1, 1, 1); PG8_SCHED; PG8_LDA(At, 1, 0); PG8_STAGE(PG8_SA(0, 1), a2 + hstep, voffA);
            PG8_WAIT_V(8); PG8_WAIT_L(0); PG8_BAR; PG8_MMA(0, 0, At, B0); PG8_MMA(0, 1, At, B1); PG8_BAR; PG8_SCHED;
            PG8_LDA(At, 1, 1); PG8_STAGE(PG8_SB(1, 0), b3, voffB); PG8_STAGE(PG8_SB(1, 1), b3 + hstep, voffB); PG8_STAGE(PG8_SA(1, 0), a3, voffA);
            PG8_WAIT_V(8); PG8_WAIT_L(0); PG8_BAR; PG8_MMA(1, 0, At, B0); PG8_MMA(1, 1, At, B1); PG8_BAR; PG8_SCHED;
        }
        if (wr == 0) PG8_BAR;
        E(acc, cur, wr, wc, fr, fq);
        if (!has_next) break;
#pragma unroll
        for (int a = 0; a < 2; ++a)
#pragma unroll
            for (int b = 0; b < 2; ++b)
#pragma unroll
                for (int m = 0; m < 4; ++m)
#pragma unroll
                    for (int n = 0; n < 2; ++n) acc[a][b][m][n] = (f32x4){0.f, 0.f, 0.f, 0.f};
        cur = nxt; cA = nA; cB = nB; ++ui;
        if (wr == 1) PG8_BAR;
    }
    PG8_WAIT_V(0);
    PG8_BAR;
#undef PG8_SA
#undef PG8_SB
#undef PG8_STAGE
#undef PG8_LDA
#undef PG8_LDB
#undef PG8_MMA
#undef PG8_WAIT_V
#undef PG8_WAIT_L
#undef PG8_BAR
#undef PG8_SCHED
}

struct EpiProj {
    static constexpr bool PERM = true;
    bf16_t* O; const float* cosT; const float* sinT;
    __device__ __forceinline__ void operator()(const f32x4 (&acc)[2][2][4][2], const Unit& u, int wr, int wc, int fr, int fq) const {
        const int row0 = u.pm * BM + wr * 64 + fr, col0 = u.pn * BM + wc * 32 + 8 * fq;
        const bool rope = (u.pm < 256) && (u.pn < 4);
        const float sgn = (fq & 2) ? 1.f : -1.f; const int lane_ = (fq << 4) | fr;
#pragma unroll
        for (int ai = 0; ai < 2; ++ai)
#pragma unroll
            for (int m = 0; m < 4; ++m) {
                const int r = row0 + ai * HALF + m * 16;
                f32x4 c0 = {1.f, 1.f, 1.f, 1.f}, c1 = c0, s0 = {0.f, 0.f, 0.f, 0.f}, s1 = s0;
                if (rope) { const int p = r & (SEQ - 1); const int pos = (wc & 1) ? (p & 63) : (p >> 6); const int f0 = 8 * (fq & 1);
                    c0 = *(const f32x4*)(cosT + pos * 16 + f0); c1 = *(const f32x4*)(cosT + pos * 16 + f0 + 4);
                    s0 = *(const f32x4*)(sinT + pos * 16 + f0); s1 = *(const f32x4*)(sinT + pos * 16 + f0 + 4); }
                if (u.pn == 7 || u.pn == 8) {
                    const f32x4 u0 = acc[ai][0][m][0] * acc[ai][1][m][0], u1 = acc[ai][0][m][1] * acc[ai][1][m][1];
                    u32x4 w; w.x = cvt_pk_bf16(u0[0], u0[1]); w.y = cvt_pk_bf16(u0[2], u0[3]); w.z = cvt_pk_bf16(u1[0], u1[1]); w.w = cvt_pk_bf16(u1[2], u1[3]);
                    *(u32x4*)(O + (size_t)r * INC + 1792 + (u.pn - 7) * HALF + wc * 32 + 8 * fq) = w; continue; }
                bf16_t* rowp = O + (size_t)r * INC + col0;
#pragma unroll
                for (int bj = 0; bj < 2; ++bj) { f32x4 v0 = acc[ai][bj][m][0], v1 = acc[ai][bj][m][1];
                    if (rope) {
#pragma unroll
                        for (int j = 0; j < 4; ++j) { const float p0 = bperm_xor(v0[j], 32, lane_), p1 = bperm_xor(v1[j], 32, lane_);
                            v0[j] = v0[j] * c0[j] + sgn * p0 * s0[j]; v1[j] = v1[j] * c1[j] + sgn * p1 * s1[j]; } }
                    u32x4 w; w.x = cvt_pk_bf16(v0[0], v0[1]); w.y = cvt_pk_bf16(v0[2], v0[3]); w.z = cvt_pk_bf16(v1[0], v1[1]); w.w = cvt_pk_bf16(v1[2], v1[3]);
                    *(u32x4*)(rowp + bj * HALF) = w; } }
    }
};
struct EpiResB {
    static constexpr bool PERM = true;
    bf16_t* X; const float* gate;
    __device__ __forceinline__ void operator()(const f32x4 (&acc)[2][2][4][2], const Unit& u, int wr, int wc, int fr, int fq) const {
        const int b = (u.pm < 256) ? (u.pm >> 3) : 32;
        const int row0 = u.pm * BM + wr * 64 + fr, col0 = u.pn * BM + wc * 32 + 8 * fq;
        f32x4 gv[2][2];
#pragma unroll
        for (int bj = 0; bj < 2; ++bj)
#pragma unroll
            for (int n = 0; n < 2; ++n) gv[bj][n] = *(const f32x4*)(gate + (size_t)b * (NMOD * DM) + col0 + bj * HALF + n * 4);
#pragma unroll
        for (int ai = 0; ai < 2; ++ai) {
            u32x4 xv[4][2];
#pragma unroll
            for (int m = 0; m < 4; ++m)
#pragma unroll
                for (int bj = 0; bj < 2; ++bj) xv[m][bj] = *(const u32x4*)(X + (size_t)(row0 + ai * HALF + m * 16) * DM + col0 + bj * HALF);
#pragma unroll
            for (int m = 0; m < 4; ++m)
#pragma unroll
                for (int bj = 0; bj < 2; ++bj) { const u32x4 xw = xv[m][bj]; const f32x4 a0 = acc[ai][bj][m][0] * gv[bj][0], a1 = acc[ai][bj][m][1] * gv[bj][1];
                    u32x4 w;
                    w.x = cvt_pk_bf16(__uint_as_float(xw.x << 16) + a0[0], __uint_as_float(xw.x & 0xffff0000u) + a0[1]);
                    w.y = cvt_pk_bf16(__uint_as_float(xw.y << 16) + a0[2], __uint_as_float(xw.y & 0xffff0000u) + a0[3]);
                    w.z = cvt_pk_bf16(__uint_as_float(xw.z << 16) + a1[0], __uint_as_float(xw.z & 0xffff0000u) + a1[1]);
                    w.w = cvt_pk_bf16(__uint_as_float(xw.w << 16) + a1[2], __uint_as_float(xw.w & 0xffff0000u) + a1[3]);
                    *(u32x4*)(X + (size_t)(row0 + ai * HALF + m * 16) * DM + col0 + bj * HALF) = w; } }
    }
};
struct EpiResNorm {
    static constexpr bool PERM = true;
    bf16_t* X; const float* gate; bool fuse;
    bf16_t* H; const float* gw; const float* modn; int shi, sci;
    float* xch; LAS unsigned char* tab;
    float* F; int mstride;
    float* slab; unsigned* skc;
    __device__ __forceinline__ void operator()(f32x4 (&acc)[2][2][4][2], const Unit& u, int wr, int wc, int fr, int fq) const {
        if (u.role) {
            const int wv = wr * 4 + wc, ln = (fq << 4) | fr; unsigned* pc = skc + (size_t)u.ui * 64;
            char* sb = (char*)slab + ((size_t)(u.ui * 8 + wv) * 32 * 64 + ln) * 16 + 4096;
#define SK_ST(q, v, OFF) asm volatile("global_store_dwordx4 %0, %1, off offset:%2 sc1" :: "v"(q), "v"(v), "i"(OFF) : "memory")
#define SK_LD(t, q, OFF) asm volatile("global_load_dwordx4 %0, %1, off offset:%2 sc1" : "=&v"(t) : "v"(q), "i"(OFF) : "memory")
            const bool helper = (u.role == 2);
            if (!helper) for (int spin = 0; spin < (1 << 22); ++spin) {
                if ((unsigned)__builtin_amdgcn_readfirstlane(__hip_atomic_load(pc, __ATOMIC_RELAXED, __HIP_MEMORY_SCOPE_AGENT)) >= 8u) break;
                __builtin_amdgcn_s_sleep(1); }
#pragma unroll
            for (int ai = 0; ai < 2; ++ai)
#pragma unroll
                for (int bj = 0; bj < 2; ++bj)
#pragma unroll
                    for (int mh = 0; mh < 2; ++mh) { char* q = sb + (ai * 2 + bj) * 8192 + mh * 4096;
                        if (helper) { SK_ST(q, acc[ai][bj][2 * mh][0], -4096); SK_ST(q, acc[ai][bj][2 * mh][1], -3072); SK_ST(q, acc[ai][bj][2 * mh + 1][0], -2048); SK_ST(q, acc[ai][bj][2 * mh + 1][1], -1024); }
                        else { f32x4 t0, t1; SK_LD(t0, q, -4096); SK_LD(t1, q, -3072);
                            asm volatile("s_waitcnt vmcnt(0)" : "+v"(t0), "+v"(t1) :: "memory");
                            acc[ai][bj][2 * mh][0] += t0; acc[ai][bj][2 * mh][1] += t1;
                            SK_LD(t0, q, -2048); SK_LD(t1, q, -1024);
                            asm volatile("s_waitcnt vmcnt(0)" : "+v"(t0), "+v"(t1) :: "memory");
                            acc[ai][bj][2 * mh + 1][0] += t0; acc[ai][bj][2 * mh + 1][1] += t1; } }
            if (helper) { asm volatile("s_waitcnt vmcnt(0)" ::: "memory");
                if (ln == 0) __hip_atomic_fetch_add(pc, 1u, __ATOMIC_RELAXED, __HIP_MEMORY_SCOPE_AGENT);
                return; }
#undef SK_ST
#undef SK_LD
        }
        const int b = (u.pm < 256) ? (u.pm >> 3) : 32;
        const int row0 = u.pm * BM + wr * 64 + fr, col0 = u.pn * BM + wc * 32 + 8 * fq;
        { f32x4 gv[2][2];
#pragma unroll
          for (int bj = 0; bj < 2; ++bj)
#pragma unroll
            for (int n = 0; n < 2; ++n) gv[bj][n] = *(const f32x4*)(gate + (size_t)b * (NMOD * DM) + col0 + bj * HALF + n * 4);
#pragma unroll
          for (int ai = 0; ai < 2; ++ai) {
            u32x4 xv[4][2];
#pragma unroll
            for (int m = 0; m < 4; ++m)
#pragma unroll
                for (int bj = 0; bj < 2; ++bj) xv[m][bj] = *(const u32x4*)(X + (size_t)(row0 + ai * HALF + m * 16) * DM + col0 + bj * HALF);
#pragma unroll
            for (int m = 0; m < 4; ++m)
#pragma unroll
                for (int bj = 0; bj < 2; ++bj) { const u32x4 xw = xv[m][bj]; f32x4 a0 = acc[ai][bj][m][0] * gv[bj][0], a1 = acc[ai][bj][m][1] * gv[bj][1];
                    a0[0] += __uint_as_float(xw.x << 16); a0[1] += __uint_as_float(xw.x & 0xffff0000u); a0[2] += __uint_as_float(xw.y << 16); a0[3] += __uint_as_float(xw.y & 0xffff0000u);
                    a1[0] += __uint_as_float(xw.z << 16); a1[1] += __uint_as_float(xw.z & 0xffff0000u); a1[2] += __uint_as_float(xw.w << 16); a1[3] += __uint_as_float(xw.w & 0xffff0000u);
                    acc[ai][bj][m][0] = a0; acc[ai][bj][m][1] = a1; } } }
        const int tid = threadIdx.x;
        LAS float* Pt = (LAS float*)tab; LAS float* St = (LAS float*)(tab + 4096);
        if (fuse) {
#pragma unroll
            for (int ai = 0; ai < 2; ++ai)
#pragma unroll
                for (int m = 0; m < 4; ++m) { float q = 0.f;
#pragma unroll
                    for (int bj = 0; bj < 2; ++bj)
#pragma unroll
                        for (int n = 0; n < 2; ++n) { const f32x4 x = acc[ai][bj][m][n]; q += (x[0] * x[0] + x[1] * x[1]) + (x[2] * x[2] + x[3] * x[3]); }
                    q += bperm_xor(q, 16, (fq << 4) | fr); q += bperm_xor(q, 32, (fq << 4) | fr);
                    if (fq == 0) Pt[(ai * HALF + wr * 64 + m * 16 + fr) * 4 + wc] = q; }
            asm volatile("s_waitcnt lgkmcnt(0)" ::: "memory"); __builtin_amdgcn_s_barrier(); asm volatile("" ::: "memory");
            if (tid < 256) { const float t = (Pt[tid * 4 + 0] + Pt[tid * 4 + 1]) + (Pt[tid * 4 + 2] + Pt[tid * 4 + 3]);
                __hip_atomic_store(xch + ((size_t)u.pm * BM + tid) * 4 + u.pn, t, __ATOMIC_RELAXED, __HIP_MEMORY_SCOPE_AGENT); }
        }
#pragma unroll
        for (int ai = 0; ai < 2; ++ai)
#pragma unroll
            for (int m = 0; m < 4; ++m)
#pragma unroll
                for (int bj = 0; bj < 2; ++bj) { const f32x4 a0 = acc[ai][bj][m][0], a1 = acc[ai][bj][m][1];
                    u32x4 w; w.x = cvt_pk_bf16(a0[0], a0[1]); w.y = cvt_pk_bf16(a0[2], a0[3]); w.z = cvt_pk_bf16(a1[0], a1[1]); w.w = cvt_pk_bf16(a1[2], a1[3]);
                    *(u32x4*)(X + (size_t)(row0 + ai * HALF + m * 16) * DM + col0 + bj * HALF) = w; }
        if (!fuse) return;
        if (tid < 256) { const float* sl = xch + ((size_t)u.pm * BM + tid) * 4; f32x4 v;
            for (int spin = 0; spin < (1 << 22); ++spin) {
                asm volatile("global_load_dwordx4 %0, %1, off sc1\n\ts_waitcnt vmcnt(0)" : "=&v"(v) : "v"(sl) : "memory");
                const bool ok = (v[0] >= 0.f) && (v[1] >= 0.f) && (v[2] >= 0.f) && (v[3] >= 0.f);
                if (__all(ok)) break;
                __builtin_amdgcn_s_sleep(1); }
            St[tid] = rsqrtf(((v[0] + v[1]) + (v[2] + v[3])) * (1.f / DM) + local_const(0x358637bdu)); }
        asm volatile("s_waitcnt vmcnt(0) lgkmcnt(0)" ::: "memory"); __builtin_amdgcn_s_barrier(); asm volatile("" ::: "memory");
        const float* mb = modn + (size_t)b * mstride;
#pragma unroll
        for (int bj = 0; bj < 2; ++bj) { f32x4 gg[2], sc[2], sh[2];
#pragma unroll
            for (int n = 0; n < 2; ++n) { const int c = col0 + bj * HALF + n * 4; gg[n] = *(const f32x4*)(gw + c); sc[n] = *(const f32x4*)(mb + sci * DM + c) + 1.f; sh[n] = *(const f32x4*)(mb + shi * DM + c); gg[n] = gg[n] * sc[n]; }
#pragma unroll
            for (int ai = 0; ai < 2; ++ai)
#pragma unroll
                for (int m = 0; m < 4; ++m) { const float rs = St[ai * HALF + wr * 64 + m * 16 + fr];
                    const f32x4 y0 = (acc[ai][bj][m][0] * rs) * gg[0] + sh[0], y1 = (acc[ai][bj][m][1] * rs) * gg[1] + sh[1];
                    if (F) { float* op = F + (size_t)(row0 + ai * HALF + m * 16) * DM + col0 + bj * HALF; *(f32x4*)op = y0; *(f32x4*)(op + 4) = y1; }
                    else { u32x4 w; w.x = cvt_pk_bf16(y0[0], y0[1]); w.y = cvt_pk_bf16(y0[2], y0[3]); w.z = cvt_pk_bf16(y1[0], y1[1]); w.w = cvt_pk_bf16(y1[2], y1[3]);
                        *(u32x4*)(H + (size_t)(row0 + ai * HALF + m * 16) * DM + col0 + bj * HALF) = w; } } }
    }
};
struct EpiSwi {
    static constexpr bool PERM = true;
    bf16_t* O;
    __device__ __forceinline__ void operator()(const f32x4 (&acc)[2][2][4][2], const Unit& u, int wr, int wc, int fr, int fq) const {
        const int row0 = u.pm * BM + wr * 64 + fr, col0 = u.pn * HALF + wc * 32 + 8 * fq;
#pragma unroll
        for (int ai = 0; ai < 2; ++ai)
#pragma unroll
            for (int m = 0; m < 4; ++m) { float h[8];
#pragma unroll
                for (int n = 0; n < 2; ++n)
#pragma unroll
                    for (int j = 0; j < 4; ++j) { const float gt = acc[ai][0][m][n][j], up = acc[ai][1][m][n][j];
                        h[n * 4 + j] = gt * __builtin_amdgcn_rcpf(1.f + __builtin_amdgcn_exp2f(-1.4426950408889634f * gt)) * up; }
                u32x4 w; w.x = cvt_pk_bf16(h[0], h[1]); w.y = cvt_pk_bf16(h[2], h[3]); w.z = cvt_pk_bf16(h[4], h[5]); w.w = cvt_pk_bf16(h[6], h[7]);
                *(u32x4*)(O + (size_t)(row0 + ai * HALF + m * 16) * FFN + col0) = w; }
    }
};
}

namespace att {
constexpr int KVBLK = 64;
constexpr float SCALE = 0.125f, THR = 8.f;
constexpr int SHM_V = KVBLK * 128 * 2, SHM_K = KVBLK * 128 * 2;
constexpr int OX_STRIDE = 144;
constexpr int OX_BYTES = 128 * OX_STRIDE * 4;
constexpr int WSCR_OFF = 2 * OX_BYTES;
#define KSWZ(row, colB) ((row) * 256 + ((colB) ^ (((row) & 15) << 4)))
#define SBAR() __builtin_amdgcn_sched_barrier(0)
__device__ __forceinline__ int crow(int r, int hi) { return (r & 3) + 8 * (r >> 2) + 4 * hi; }

__device__ __forceinline__ void partialSM(f32x16& p0, f32x16& p1, float& m_reg, float& mn, float& alpha) {
  constexpr float C = SCALE * 1.4426950408889634f;
  float pmax = p0[0];
#pragma unroll
  for (int r = 1; r < 16; ++r) pmax = fmaxf(pmax, p0[r]);
#pragma unroll
  for (int r = 0; r < 16; ++r) pmax = fmaxf(pmax, p1[r]);
  { auto rr = __builtin_amdgcn_permlane32_swap(__float_as_uint(pmax), __float_as_uint(pmax), false, false);
    pmax = fmaxf(__uint_as_float(rr[0]), __uint_as_float(rr[1])); }
  if (__builtin_expect(__all(pmax - m_reg <= THR / SCALE), 1)) { mn = m_reg; alpha = 1.f; }
  else { mn = fmaxf(m_reg, pmax); alpha = __builtin_amdgcn_exp2f((m_reg - mn) * C); m_reg = mn; }
  float mnC = -mn * C;
#pragma unroll
  for (int r = 0; r < 16; ++r) p0[r] = fmaf(p0[r], C, mnC);
#pragma unroll
  for (int r = 0; r < 16; ++r) p1[r] = fmaf(p1[r], C, mnC);
#pragma unroll
  for (int r = 0; r < 16; ++r) p0[r] = __builtin_amdgcn_exp2f(p0[r]);
}
__device__ __forceinline__ void finishSM(f32x16& p0, f32x16& p1, float alpha, float& l_reg, bf16x8& pa0, bf16x8& pa1, bf16x8& pa2, bf16x8& pa3) {
#pragma unroll
  for (int r = 0; r < 16; ++r) p1[r] = __builtin_amdgcn_exp2f(p1[r]);
  float ps = 0;
#pragma unroll
  for (int r = 0; r < 16; ++r) ps += p0[r];
#pragma unroll
  for (int r = 0; r < 16; ++r) ps += p1[r];
  { auto rr = __builtin_amdgcn_permlane32_swap(__float_as_uint(ps), __float_as_uint(ps), false, false);
    ps = __uint_as_float(rr[0]) + __uint_as_float(rr[1]); }
  l_reg = l_reg * alpha + ps;
#define PK4(P, BASE, OUT) do { unsigned a0 = cvt_pk_bf16(P[BASE + 0], P[BASE + 1]), a1 = cvt_pk_bf16(P[BASE + 2], P[BASE + 3]);   \
    unsigned b0 = cvt_pk_bf16(P[BASE + 4], P[BASE + 5]), b1 = cvt_pk_bf16(P[BASE + 6], P[BASE + 7]);                              \
    auto r0 = __builtin_amdgcn_permlane32_swap(a0, b0, false, false); auto r1 = __builtin_amdgcn_permlane32_swap(a1, b1, false, false); \
    u32x4 w = {r0[0], r1[0], r0[1], r1[1]}; OUT = *reinterpret_cast<bf16x8*>(&w); } while (0)
  PK4(p0, 0, pa0); PK4(p0, 8, pa1); PK4(p1, 0, pa2); PK4(p1, 8, pa3);
#undef PK4
}
__device__ __forceinline__ void qkt(f32x16& p0, f32x16& p1, const char* Ks, const bf16x8* qr, int r32, int hi, int cmapB) {
  p0 = f32x16{}; p1 = f32x16{};
#pragma unroll
  for (int d0 = 0; d0 < 4; ++d0) { int cb = cmapB + (d0 * 16 + hi * 8) * 2;
    bf16x8 b0 = *reinterpret_cast<const bf16x8*>(Ks + KSWZ(r32, cb));
    bf16x8 b1 = *reinterpret_cast<const bf16x8*>(Ks + KSWZ(32 + r32, cb));
    p0 = __builtin_amdgcn_mfma_f32_32x32x16_bf16(b0, qr[d0], p0, 0, 0, 0);
    p1 = __builtin_amdgcn_mfma_f32_32x32x16_bf16(b1, qr[d0], p1, 0, 0, 0); }
}
__device__ __forceinline__ int v_st(int k, int c) { const int kk = (k & ~0xC) | ((k & 4) << 1) | ((k & 8) >> 1); return ((kk >> 3) * 4 + (c >> 5)) * 512 + ((kk & 7) * 32 + (c & 31)) * 2; }
__device__ __forceinline__ int v_rd_base(int lane) { return ((lane & 3) << 3) | (((lane >> 2) & 3) << 6) | (((lane >> 4) & 1) << 5) | (((lane >> 5) & 1) << 8); }
constexpr int v_rd_off(int d0, int ks, int half) { return d0 * 512 + ks * 4096 + half * 2048; }
template <int OFF> __device__ __forceinline__ s16x4 tr_read(int vb) {
  s16x4 r; asm volatile("ds_read_b64_tr_b16 %0, %1 offset:%2" : "=&v"(r) : "v"(vb), "i"(OFF) : "memory"); return r;
}
template <int D0> __device__ __forceinline__ void pv_one(f32x16& od, int vb, bf16x8 pa0, bf16x8 pa1, bf16x8 pa2, bf16x8 pa3) {
  const s16x4 l0 = tr_read<v_rd_off(D0, 0, 0)>(vb), h0 = tr_read<v_rd_off(D0, 0, 1)>(vb), l1 = tr_read<v_rd_off(D0, 1, 0)>(vb), h1 = tr_read<v_rd_off(D0, 1, 1)>(vb);
  const s16x4 l2 = tr_read<v_rd_off(D0, 2, 0)>(vb), h2 = tr_read<v_rd_off(D0, 2, 1)>(vb), l3 = tr_read<v_rd_off(D0, 3, 0)>(vb), h3 = tr_read<v_rd_off(D0, 3, 1)>(vb);
  asm volatile("s_waitcnt lgkmcnt(0)" ::: "memory"); SBAR();
#define PK(L, H) (bf16x8){L[0], L[1], L[2], L[3], H[0], H[1], H[2], H[3]}
  od = __builtin_amdgcn_mfma_f32_32x32x16_bf16(pa0, PK(l0, h0), od, 0, 0, 0);
  od = __builtin_amdgcn_mfma_f32_32x32x16_bf16(pa1, PK(l1, h1), od, 0, 0, 0);
  od = __builtin_amdgcn_mfma_f32_32x32x16_bf16(pa2, PK(l2, h2), od, 0, 0, 0);
  od = __builtin_amdgcn_mfma_f32_32x32x16_bf16(pa3, PK(l3, h3), od, 0, 0, 0);
#undef PK
}
__device__ __forceinline__ void pv_d0(f32x16* o, int vb, bf16x8 pa0, bf16x8 pa1, bf16x8 pa2, bf16x8 pa3) {
  pv_one<0>(o[0], vb, pa0, pa1, pa2, pa3); pv_one<1>(o[1], vb, pa0, pa1, pa2, pa3); pv_one<2>(o[2], vb, pa0, pa1, pa2, pa3); pv_one<3>(o[3], vb, pa0, pa1, pa2, pa3);
}

__device__ __forceinline__ void attn_item(const bf16_t* __restrict__ proj, bf16_t* __restrict__ mix, int qrow0, int h, int crow0, int lrow0, int NT,
                                       float lam, float postscale, const float* __restrict__ gsub, char* lds) {
  const int tid = opaque_tid(), wid = tid >> 6, lane = tid & 63, r32 = lane & 31, hi = lane >> 5;
  const int cmap = wid >> 2, wq = wid & 3, cmapB = cmap * 128;
  char* V_lds = lds; char* K_lds = lds + 2 * SHM_V;
  float* wsx = (float*)(lds + WSCR_OFF) + wid * 64; float* li_l = wsx; float* al_l = wsx + 32;
  float m_reg = local_const(0xf149f2cau)  , l_reg = 0; f32x16 o[4] = {}; bf16x8 qr[4];
  const bf16_t* Qw = proj + (size_t)(qrow0 + wq * 32 + r32) * INC + h * 128 + cmap * 64 + hi * 8;
#pragma unroll
  for (int d0 = 0; d0 < 4; ++d0) qr[d0] = *reinterpret_cast<const bf16x8*>(Qw + d0 * 16);
  const int sr = tid >> 4, sc = (tid & 15) * 8, vst0 = v_st(sr, sc), vst1 = v_st(32 + sr, sc);
  const int vb0 = (int)(uintptr_t)V_lds + v_rd_base(lane);
  const bf16_t* Kbase = proj + 512 + h * 128 + sc; const bf16_t* Vbase = proj + 1024 + h * 128 + sc;
  struct { bf16x8 vs0, vs1, ks0, ks1; } sr_[2];
#define KROW(k0) ((k0) < 256 ? crow0 + (k0) : lrow0 + (k0) - 256)
#define SLOAD(i, k0) do { const size_t _r0 = (size_t)(KROW(k0) + sr) * INC, _r1 = _r0 + (size_t)32 * INC; \
    sr_[i].vs0 = *reinterpret_cast<const bf16x8*>(Vbase + _r0); sr_[i].vs1 = *reinterpret_cast<const bf16x8*>(Vbase + _r1); \
    sr_[i].ks0 = *reinterpret_cast<const bf16x8*>(Kbase + _r0); sr_[i].ks1 = *reinterpret_cast<const bf16x8*>(Kbase + _r1); } while (0)
#define SWRITE(b, i) do { *(bf16x8*)(V_lds + (b) * SHM_V + vst0) = sr_[i].vs0;          \
    *(bf16x8*)(V_lds + (b) * SHM_V + vst1) = sr_[i].vs1; int kc = sc * 2;               \
    *(bf16x8*)(K_lds + (b) * SHM_K + KSWZ(sr, kc)) = sr_[i].ks0;                       \
    *(bf16x8*)(K_lds + (b) * SHM_K + KSWZ(32 + sr, kc)) = sr_[i].ks1; } while (0)
#define SWAIT() asm volatile("s_waitcnt vmcnt(4)" ::: "memory")
#define RESC(a) do { if (__any((a) < 1.f)) { if (hi == 0) al_l[r32] = (a); asm volatile("s_waitcnt lgkmcnt(0)" ::: "memory"); \
    _Pragma("unroll") for (int d = 0; d < 4; ++d) _Pragma("unroll") for (int r = 0; r < 16; ++r) o[d][r] *= al_l[crow(r, hi)]; } } while (0)
  f32x16 pA0, pA1, pB0, pB1; float mnA, mnB, alA, alB; bf16x8 pa0, pa1, pa2, pa3;
  constexpr int SE = 0, SO = 1;
  SLOAD(SE, 0); SLOAD(SO, KVBLK);
  SWRITE(0, SE); SLOAD(SE, 2 * KVBLK); __syncthreads();
  qkt(pA0, pA1, K_lds, qr, r32, hi, cmapB); partialSM(pA0, pA1, m_reg, mnA, alA);
  SWAIT(); SWRITE(1, SO); __syncthreads();
  for (int j = 1; j + 1 < NT; j += 2) {
    SBAR(); qkt(pB0, pB1, K_lds + SHM_K, qr, r32, hi, cmapB);
    finishSM(pA0, pA1, alA, l_reg, pa0, pa1, pa2, pa3); SBAR();
    SLOAD(SO, (j + 2) * KVBLK); SBAR();
    pv_d0(o, vb0, pa0, pa1, pa2, pa3); partialSM(pB0, pB1, m_reg, mnB, alB);
    __syncthreads(); SWAIT(); SWRITE(0, SE);
    RESC(alB); __syncthreads();
    SBAR(); qkt(pA0, pA1, K_lds, qr, r32, hi, cmapB);
    finishSM(pB0, pB1, alB, l_reg, pa0, pa1, pa2, pa3); SBAR();
    SLOAD(SE, (j + 3 < NT ? j + 3 : NT - 1) * KVBLK); SBAR();
    pv_d0(o, vb0 + SHM_V, pa0, pa1, pa2, pa3); partialSM(pA0, pA1, m_reg, mnA, alA);
    __syncthreads(); SWAIT(); SWRITE(1, SO);
    RESC(alA); __syncthreads();
  }
  SBAR(); qkt(pB0, pB1, K_lds + SHM_K, qr, r32, hi, cmapB);
  finishSM(pA0, pA1, alA, l_reg, pa0, pa1, pa2, pa3); SBAR();
  pv_d0(o, vb0, pa0, pa1, pa2, pa3); partialSM(pB0, pB1, m_reg, mnB, alB);
  __syncthreads(); RESC(alB);
  finishSM(pB0, pB1, alB, l_reg, pa0, pa1, pa2, pa3); SBAR();
  pv_d0(o, vb0 + SHM_V, pa0, pa1, pa2, pa3);
  if (hi == 0) li_l[r32] = l_reg; asm volatile("s_waitcnt lgkmcnt(0)" ::: "memory");
  const float msc = cmap ? lam : 1.f;
  float rli[16];
#pragma unroll
  for (int r = 0; r < 16; ++r) rli[r] = __builtin_amdgcn_rcpf(li_l[crow(r, hi)]) * msc;
  __syncthreads();
  float* OX = (float*)(lds + cmap * OX_BYTES) + (wq * 32) * OX_STRIDE;
#pragma unroll
  for (int r = 0; r < 16; ++r) { const int orow = crow(r, hi);
#pragma unroll
    for (int d0 = 0; d0 < 4; ++d0) OX[orow * OX_STRIDE + d0 * 32 + r32] = o[d0][r] * rli[r]; }
  __syncthreads();
  { const int row = tid >> 2, q = tid & 3; const float* A = (const float*)lds + row * OX_STRIDE; const float* Bm = (const float*)(lds + OX_BYTES) + row * OX_STRIDE;
    f32x4 a[8]; float ss = 0.f;
#pragma unroll
    for (int i = 0; i < 8; ++i) { const int c4 = 4 * (q + 4 * i); a[i] = *(const f32x4*)(A + c4) - *(const f32x4*)(Bm + c4);
      ss += a[i][0] * a[i][0] + a[i][1] * a[i][1] + a[i][2] * a[i][2] + a[i][3] * a[i][3]; }
    ss += bperm_xor(ss, 1, lane); ss += bperm_xor(ss, 2, lane);
    const float rs = rsqrtf(ss * (1.f / 128.f) + local_const(0x358637bdu)) * postscale;
    bf16_t* op = mix + (size_t)(qrow0 + row) * DM + h * 128;
#pragma unroll
    for (int i = 0; i < 8; ++i) { const int c4 = 4 * (q + 4 * i); const f32x4 g4 = *(const f32x4*)(gsub + c4); const f32x4 v = a[i] * g4 * rs;
      u32x2 w; w.x = cvt_pk_bf16(v[0], v[1]); w.y = cvt_pk_bf16(v[2], v[3]); *(u32x2*)(op + c4) = w; } }
  __syncthreads();
#undef KROW
#undef SLOAD
#undef SWRITE
#undef SWAIT
#undef RESC
}
}

__device__ __forceinline__ float bf2f(unsigned short b) { return __uint_as_float(((unsigned)b) << 16); }
__device__ __forceinline__ void unpack8(const bf16x8 v, float* f) {
#pragma unroll
  for (int j = 0; j < 8; ++j) f[j] = bf2f((unsigned short)v[j]);
}
__device__ __forceinline__ void mixer_item(const bf16_t* __restrict__ proj, bf16_t* __restrict__ mix, int rb, int p0, int Ls,
                                        const float* __restrict__ wconv, const float* __restrict__ spool, char* lds) {
  const int tid = opaque_tid();
  constexpr int HS = 528;
  char* HT = lds;
  char* PT = lds + 80 * HS;
  bf16x8 hv[5];
#pragma unroll
  for (int k = 0; k < 5; ++k) { const int id = tid + k * NTHREADS; const int rr = id >> 5, ch = (id & 31) * 8; const int p = p0 - 8 + rr;
    hv[k] = (bf16x8){0, 0, 0, 0, 0, 0, 0, 0};
    if (id < 79 * 32 && p >= 0 && p < Ls) hv[k] = *reinterpret_cast<const bf16x8*>(proj + (size_t)(rb - 8 + rr) * INC + 2304 + ch); }
  bf16x8 rbg[4], ru0[4], rum[4], rup[4];
#pragma unroll
  for (int k = 0; k < 4; ++k) { const int id = tid + k * NTHREADS; const int tok = id >> 5, ch = (id & 31) * 8; const int p = p0 + tok;
    const bf16_t* rp = proj + (size_t)(rb + tok) * INC + 1536 + ch;
    const bf16_t* rm = (p > 0) ? rp - INC : rp; const bf16_t* rq = (p + 1 < Ls) ? rp + INC : rp;
    rbg[k] = *reinterpret_cast<const bf16x8*>(rp); ru0[k] = *reinterpret_cast<const bf16x8*>(rp + 256);
    rum[k] = *reinterpret_cast<const bf16x8*>(rm + 256); rup[k] = *reinterpret_cast<const bf16x8*>(rq + 256); }
#pragma unroll
  for (int k = 0; k < 5; ++k) { const int id = tid + k * NTHREADS; const int rr = id >> 5, ch = (id & 31) * 8;
    if (id < 79 * 32) *(bf16x8*)(HT + rr * HS + ch * 2) = hv[k]; }
#pragma unroll
  for (int k = 0; k < 4; ++k) { const int id = tid + k * NTHREADS; const int tok = id >> 5, ch = (id & 31) * 8; const int p = p0 + tok;
    float bg[8], um[8], u0[8], up[8], w0[8], w1[8], w2[8];
    unpack8(rbg[k], bg); unpack8(ru0[k], u0); unpack8(rum[k], um); unpack8(rup[k], up);
#pragma unroll
    for (int q = 0; q < 2; ++q) { const f32x4 a0 = *(const f32x4*)(wconv + ch + q * 4), a1 = *(const f32x4*)(wconv + 256 + ch + q * 4), a2 = *(const f32x4*)(wconv + 512 + ch + q * 4);
#pragma unroll
      for (int e = 0; e < 4; ++e) { w0[q * 4 + e] = a0[e]; w1[q * 4 + e] = a1[e]; w2[q * 4 + e] = a2[e]; } }
    const float fm = (p > 0) ? 1.f : 0.f, fp = (p + 1 < Ls) ? 1.f : 0.f;
    float y[8];
#pragma unroll
    for (int j = 0; j < 8; ++j) y[j] = bg[j] * (fm * um[j] * w0[j] + u0[j] * w1[j] + fp * up[j] * w2[j]);
    u32x4 w; w.x = cvt_pk_bf16(y[0], y[1]); w.y = cvt_pk_bf16(y[2], y[3]); w.z = cvt_pk_bf16(y[4], y[5]); w.w = cvt_pk_bf16(y[6], y[7]);
    *(u32x4*)(mix + (size_t)(rb + tok) * DM + 512 + ch) = w; }
  __syncthreads();
#pragma unroll
  for (int g = 0; g < 4; ++g) { const int hw = 1 << g; const int tok = tid >> 3, c0 = g * 64 + (tid & 7) * 8, colb = c0 * 2; const int p = p0 + tok;
    float sm[8] = {0.f, 0.f, 0.f, 0.f, 0.f, 0.f, 0.f, 0.f};
#pragma unroll
    for (int q = -hw; q < hw; ++q) { float f[8]; unpack8(*(const bf16x8*)(HT + (tok + 8 + q) * HS + colb), f);
#pragma unroll
      for (int j = 0; j < 8; ++j) sm[j] += f[j]; }
    int lo = p - hw, hi2 = p + hw - 1; if (lo < 0) lo = 0; if (hi2 > Ls - 1) hi2 = Ls - 1;
    float self[8]; unpack8(*(const bf16x8*)(HT + (tok + 8) * HS + colb), self);
    const float inv = 1.f / (float)(hi2 - lo + 1);
    const f32x4 s0 = *(const f32x4*)(spool + c0), s1 = *(const f32x4*)(spool + c0 + 4);
    float y[8];
#pragma unroll
    for (int j = 0; j < 4; ++j) { y[j] = (sm[j] * inv - self[j]) * s0[j]; y[4 + j] = (sm[4 + j] * inv - self[4 + j]) * s1[j]; }
    u32x4 w; w.x = cvt_pk_bf16(y[0], y[1]); w.y = cvt_pk_bf16(y[2], y[3]); w.z = cvt_pk_bf16(y[4], y[5]); w.w = cvt_pk_bf16(y[6], y[7]);
    *(u32x4*)(mix + (size_t)(rb + tok) * DM + 768 + c0) = w; }
  __syncthreads();
}

__device__ __forceinline__ float wave_sum(float v, int lane) {
#pragma unroll
  for (int o = 32; o >= 1; o >>= 1) v += bperm_xor(v, o, lane);
  return v;
}
__device__ __forceinline__ void unpack_bf8(const u32x4 w, float* f) {
  f[0] = __uint_as_float(w.x << 16); f[1] = __uint_as_float(w.x & 0xffff0000u); f[2] = __uint_as_float(w.y << 16); f[3] = __uint_as_float(w.y & 0xffff0000u);
  f[4] = __uint_as_float(w.z << 16); f[5] = __uint_as_float(w.z & 0xffff0000u); f[6] = __uint_as_float(w.w << 16); f[7] = __uint_as_float(w.w & 0xffff0000u);
}
__device__ __forceinline__ u32x4 pack_bf8(const float* f) { u32x4 w; w.x = cvt_pk_bf16(f[0], f[1]); w.y = cvt_pk_bf16(f[2], f[3]); w.z = cvt_pk_bf16(f[4], f[5]); w.w = cvt_pk_bf16(f[6], f[7]); return w; }
template <bool F32SRC>
__device__ __forceinline__ void norm_phase(const float* xlat, const float* xctx, bf16_t* xb, const float* g, const float* modl, int shi, int sci, bf16_t* act, int nrows) {
  constexpr int NRW = F32SRC ? 4 : 8;
  const int tid = opaque_tid(); const int lane = tid & 63; const int gw = blockIdx.x * 8 + (tid >> 6), nw = gridDim.x * 8;
  const int rpw = (nrows + nw - 1) / nw; const int r0 = gw * rpw; const int r1 = (r0 + rpw < nrows) ? r0 + rpw : nrows;
  float gg[16], scv[16], shv[16];
#pragma unroll
  for (int i = 0; i < 2; ++i)
#pragma unroll
    for (int q = 0; q < 2; ++q) { const f32x4 t = *(const f32x4*)(g + i * 512 + lane * 8 + q * 4); gg[i * 8 + q * 4 + 0] = t[0]; gg[i * 8 + q * 4 + 1] = t[1]; gg[i * 8 + q * 4 + 2] = t[2]; gg[i * 8 + q * 4 + 3] = t[3]; }
#pragma unroll
  for (int k = 0; k < 16; ++k) { scv[k] = 0.f; shv[k] = 0.f; }
  int bcur = -1;
#pragma unroll 1
  for (int rb = r0; rb < r1; rb += NRW) {
    u32x4 raw[NRW][2]; f32x4 rawf[F32SRC ? NRW : 1][4];
#pragma unroll
    for (int j = 0; j < NRW; ++j) { const int r = rb + j;
      if (F32SRC) {
#pragma unroll
        for (int i = 0; i < 4; ++i) rawf[F32SRC ? j : 0][i] = (f32x4){0.f, 0.f, 0.f, 0.f};
        if (r < r1) { const float* src = (r < MLAT) ? xlat + (size_t)r * DM : xctx + (size_t)(r - MLAT) * DM;
#pragma unroll
          for (int i = 0; i < 4; ++i) rawf[F32SRC ? j : 0][i] = *(const f32x4*)(src + (i >> 1) * 512 + lane * 8 + (i & 1) * 4); }
      } else {
        raw[j][0] = (u32x4){0u, 0u, 0u, 0u}; raw[j][1] = raw[j][0];
        if (r < r1) { raw[j][0] = *(const u32x4*)(xb + (size_t)r * DM + lane * 8); raw[j][1] = *(const u32x4*)(xb + (size_t)r * DM + 512 + lane * 8); } } }
#pragma unroll
    for (int j = 0; j < NRW; ++j) { const int r = rb + j; float v[16];
      if (F32SRC) {
#pragma unroll
        for (int i = 0; i < 4; ++i) { const f32x4 t = rawf[F32SRC ? j : 0][i]; v[i * 4 + 0] = t[0]; v[i * 4 + 1] = t[1]; v[i * 4 + 2] = t[2]; v[i * 4 + 3] = t[3]; }
      } else { unpack_bf8(raw[j][0], v); unpack_bf8(raw[j][1], v + 8); }
      float ss = 0.f;
#pragma unroll
      for (int k = 0; k < 16; ++k) ss += v[k] * v[k];
      const float rs = rsqrtf(wave_sum(ss, lane) * (1.f / DM) + local_const(0x358637bdu));
      if (r < r1) { const int b = (r < MLAT) ? (r >> 11) : 32;
        if (b != bcur) { bcur = b; const float* mb = modl + (size_t)b * (NMOD * DM);
#pragma unroll
          for (int i = 0; i < 2; ++i)
#pragma unroll
            for (int q = 0; q < 2; ++q) { const f32x4 t = *(const f32x4*)(mb + sci * DM + i * 512 + lane * 8 + q * 4), u = *(const f32x4*)(mb + shi * DM + i * 512 + lane * 8 + q * 4);
#pragma unroll
              for (int e = 0; e < 4; ++e) { scv[i * 8 + q * 4 + e] = t[e] + 1.f; shv[i * 8 + q * 4 + e] = u[e]; } } }
        if (F32SRC) { *(u32x4*)(xb + (size_t)r * DM + lane * 8) = pack_bf8(v); *(u32x4*)(xb + (size_t)r * DM + 512 + lane * 8) = pack_bf8(v + 8); }
        float y[16];
#pragma unroll
        for (int k = 0; k < 16; ++k) y[k] = (v[k] * rs) * gg[k] * scv[k] + shv[k];
        *(u32x4*)(act + (size_t)r * DM + lane * 8) = pack_bf8(y); *(u32x4*)(act + (size_t)r * DM + 512 + lane * 8) = pack_bf8(y + 8); } }
  }
}
__device__ __forceinline__ void final_norm(const bf16_t* xb, float* out, const float* g) {
  constexpr int NRW = 8;
  const int tid = opaque_tid(); const int lane = tid & 63; const int gw = blockIdx.x * 8 + (tid >> 6), nw = gridDim.x * 8;
  const int rpw = (MLAT + nw - 1) / nw; const int r0 = gw * rpw; const int r1 = (r0 + rpw < MLAT) ? r0 + rpw : MLAT;
  float gg[16];
#pragma unroll
  for (int i = 0; i < 2; ++i)
#pragma unroll
    for (int q = 0; q < 2; ++q) { const f32x4 t = *(const f32x4*)(g + i * 512 + lane * 8 + q * 4); gg[i * 8 + q * 4 + 0] = t[0]; gg[i * 8 + q * 4 + 1] = t[1]; gg[i * 8 + q * 4 + 2] = t[2]; gg[i * 8 + q * 4 + 3] = t[3]; }
#pragma unroll 1
  for (int rb = r0; rb < r1; rb += NRW) {
    u32x4 raw[NRW][2];
#pragma unroll
    for (int j = 0; j < NRW; ++j) { const int r = rb + j; raw[j][0] = (u32x4){0u, 0u, 0u, 0u}; raw[j][1] = raw[j][0];
      if (r < r1) { raw[j][0] = *(const u32x4*)(xb + (size_t)r * DM + lane * 8); raw[j][1] = *(const u32x4*)(xb + (size_t)r * DM + 512 + lane * 8); } }
#pragma unroll
    for (int j = 0; j < NRW; ++j) { const int r = rb + j; float v[16]; unpack_bf8(raw[j][0], v); unpack_bf8(raw[j][1], v + 8);
      float ss = 0.f;
#pragma unroll
      for (int k = 0; k < 16; ++k) ss += v[k] * v[k];
      const float rs = rsqrtf(wave_sum(ss, lane) * (1.f / DM) + local_const(0x358637bdu));
      if (r < r1) {
#pragma unroll
        for (int i = 0; i < 2; ++i)
#pragma unroll
          for (int q = 0; q < 2; ++q) { f32x4 o; o[0] = v[i * 8 + q * 4 + 0] * rs * gg[i * 8 + q * 4 + 0]; o[1] = v[i * 8 + q * 4 + 1] * rs * gg[i * 8 + q * 4 + 1];
            o[2] = v[i * 8 + q * 4 + 2] * rs * gg[i * 8 + q * 4 + 2]; o[3] = v[i * 8 + q * 4 + 3] * rs * gg[i * 8 + q * 4 + 3];
            *(f32x4*)(out + (size_t)r * DM + i * 512 + lane * 8 + q * 4) = o; } } }
  }
}
__device__ __forceinline__ void transpose_tile(const float* src, int ldS, bf16_t* dst, int ldD, int k0, int n0s, int n0d, float* tile) {
  const int tid = opaque_tid();
  { const int i = tid >> 3, j0 = (tid & 7) * 8; const float* p = src + (size_t)(k0 + i) * ldS + n0s + j0;
    const f32x4 a = *(const f32x4*)p, b = *(const f32x4*)(p + 4); float* t = tile + i * 65 + j0;
    t[0] = a[0]; t[1] = a[1]; t[2] = a[2]; t[3] = a[3]; t[4] = b[0]; t[5] = b[1]; t[6] = b[2]; t[7] = b[3]; }
  __syncthreads();
  { const int n = tid >> 3, kk0 = (tid & 7) * 8; float v[8];
#pragma unroll
    for (int j = 0; j < 8; ++j) v[j] = tile[(kk0 + j) * 65 + n];
    u32x4 w; w.x = cvt_pk_bf16(v[0], v[1]); w.y = cvt_pk_bf16(v[2], v[3]); w.z = cvt_pk_bf16(v[4], v[5]); w.w = cvt_pk_bf16(v[6], v[7]);
    *(u32x4*)(dst + (size_t)(n0d + n) * ldD + k0 + kk0) = w; }
  __syncthreads();
}
__device__ __forceinline__ void mod_item(const float* c, const float* cctx, const float* wada_l, const float* bada_l, float* mod_l, int n0, float* lds) {
  const int tid = opaque_tid();
  for (int i = tid; i < 33 * DM; i += NTHREADS) { const float v = (i < 32 * DM) ? c[i] : cctx[i - 32 * DM]; lds[i] = v / (1.f + __expf(-v)); }
  __syncthreads();
  const int col = tid & 127, kq = tid >> 7;
  float acc[33];
#pragma unroll
  for (int b = 0; b < 33; ++b) acc[b] = 0.f;
  const float* wp = wada_l + (size_t)(kq * 256) * (NMOD * DM) + n0 + col;
#pragma unroll 1
  for (int k = 0; k < 256; k += 8) {
    float w[8];
#pragma unroll
    for (int i = 0; i < 8; ++i) w[i] = wp[(size_t)(k + i) * (NMOD * DM)];
#pragma unroll
    for (int b = 0; b < 33; ++b) { const f32x4 s = *(const f32x4*)(lds + b * DM + kq * 256 + k), t = *(const f32x4*)(lds + b * DM + kq * 256 + k + 4);
      acc[b] += s[0] * w[0] + s[1] * w[1] + s[2] * w[2] + s[3] * w[3] + t[0] * w[4] + t[1] * w[5] + t[2] * w[6] + t[3] * w[7]; }
  }
  __syncthreads();
#pragma unroll
  for (int b = 0; b < 33; ++b) lds[(kq * 33 + b) * 128 + col] = acc[b];
  __syncthreads();
  for (int o = tid; o < 33 * 128; o += NTHREADS) { const int b = o >> 7, cc = o & 127;
    mod_l[(size_t)b * (NMOD * DM) + n0 + cc] = lds[(0 * 33 + b) * 128 + cc] + lds[(1 * 33 + b) * 128 + cc] + lds[(2 * 33 + b) * 128 + cc] + lds[(3 * 33 + b) * 128 + cc] + bada_l[n0 + cc]; }
  __syncthreads();
}

__device__ __forceinline__ void grid_bar(unsigned* ctr, unsigned target) {
  __syncthreads();
  if (threadIdx.x == 0) {
    __builtin_amdgcn_fence(__ATOMIC_RELEASE, "agent");
    asm volatile("s_waitcnt vmcnt(0)" ::: "memory");
    __hip_atomic_fetch_add(ctr, 1u, __ATOMIC_RELAXED, __HIP_MEMORY_SCOPE_AGENT);
    while (__hip_atomic_load(ctr, __ATOMIC_RELAXED, __HIP_MEMORY_SCOPE_AGENT) < target) __builtin_amdgcn_s_sleep(2);
    __builtin_amdgcn_fence(__ATOMIC_ACQUIRE, "agent");
    asm volatile("s_waitcnt vmcnt(0)" ::: "memory");
  }
  __syncthreads();
}
__global__ void __launch_bounds__(NTHREADS, 2) fwd_megakernel(Params P) {
  extern __shared__ __attribute__((aligned(16))) unsigned char lds[];
  cg::grid_group grid = cg::this_grid();
  const int tid = threadIdx.x, G = gridDim.x, bid = blockIdx.x;
  unsigned char* ws = P.ws;
  bf16_t* H2 = (bf16_t*)(ws + WS_H2); float* XCH = (float*)(ws + WS_XCH); unsigned* CNT = (unsigned*)(ws + WS_CNT); float* SLAB = (float*)(ws + WS_SLAB); unsigned* SKC = (unsigned*)(ws + WS_SKC);
  bf16_t* XB = (bf16_t*)(ws + WS_XB); bf16_t* ACT = (bf16_t*)(ws + WS_ACT); bf16_t* PROJ = (bf16_t*)(ws + WS_PROJ);
  bf16_t* WB = (bf16_t*)(ws + WS_W); float* MOD = (float*)(ws + WS_MOD);
  float* ROPE = (float*)(ws + WS_ROPE); float* LAMV = (float*)(ws + WS_LAM);
  const float* x_in = P.in[0]; const float* ctx_in = P.in[2];

  for (int rep = 0; rep < ((DUP & 8) ? 2 : 1); ++rep)
  if constexpr (EN(0)) {
    constexpr int TILES_L = 640 + 256 + 1408 + 704 + 4;
    const int nItems = 192 + DEPTH * TILES_L + 1;
    for (int it = bid; it < nItems; it += G) {
      if (it < 192) { const int l = it / 48, nb = it % 48;
        mod_item(P.in[1], P.in[3], P.in[4] + (size_t)l * DM * NMOD * DM, P.in[5] + (size_t)l * NMOD * DM, MOD + (size_t)l * 33 * NMOD * DM, nb * 128, (float*)lds);
      } else if (it < 192 + DEPTH * TILES_L) {
        const int t = it - 192; const int l = t / TILES_L; int r = t % TILES_L; bf16_t* wl = WB + (size_t)l * W_LAYER_E; float* tile = (float*)lds;
        if (r < 640 && (r % 40) >= 36) {
          const int g = (r % 40) - 36, k0 = (r / 40) * 64; const int i = tid >> 3, j0 = (tid & 7) * 8; float* At = tile; float* Wt = tile + 64 * 65;
          { const float* pa = P.in[7] + (size_t)l * DM * INC + (size_t)(k0 + i) * INC + 2304 + g * 64 + j0; const float* pw = P.in[14] + (size_t)(l * 4 + g) * 4096 + i * 64 + j0;
            const f32x4 a0 = *(const f32x4*)pa, a1 = *(const f32x4*)(pa + 4), w0 = *(const f32x4*)pw, w1 = *(const f32x4*)(pw + 4);
#pragma unroll
            for (int e = 0; e < 4; ++e) { At[i * 65 + j0 + e] = a0[e]; At[i * 65 + j0 + 4 + e] = a1[e]; Wt[i * 64 + j0 + e] = w0[e]; Wt[i * 64 + j0 + 4 + e] = w1[e]; } }
          __syncthreads();
          float o[8] = {0.f, 0.f, 0.f, 0.f, 0.f, 0.f, 0.f, 0.f};
          for (int c = 0; c < 64; ++c) { const float a = At[i * 65 + c]; const f32x4 w0 = *(const f32x4*)(Wt + c * 64 + j0), w1 = *(const f32x4*)(Wt + c * 64 + j0 + 4);
#pragma unroll
            for (int e = 0; e < 4; ++e) { o[e] += a * w0[e]; o[4 + e] += a * w1[e]; } }
          __syncthreads();
#pragma unroll
          for (int e = 0; e < 8; ++e) At[i * 65 + j0 + e] = o[e];
          __syncthreads();
          { const int n = tid >> 3, kk0 = (tid & 7) * 8; float v[8];
#pragma unroll
            for (int j = 0; j < 8; ++j) v[j] = At[(kk0 + j) * 65 + n];
            u32x4 w; w.x = cvt_pk_bf16(v[0], v[1]); w.y = cvt_pk_bf16(v[2], v[3]); w.z = cvt_pk_bf16(v[4], v[5]); w.w = cvt_pk_bf16(v[6], v[7]);
            *(u32x4*)(wl + (size_t)(2304 + g * 64 + n) * DM + k0 + kk0) = w; }
          __syncthreads();
        } else if (r < 640) { const int n0 = (r % 40) * 64; int nd = n0;
          if (n0 >= 1792 && n0 < 2304) { const int xin = n0 >= 2048; const int c = n0 - (xin ? 2048 : 1792); nd = 1792 + (c / 128) * 256 + (xin ? 128 : 0) + (c % 128); }
          transpose_tile(P.in[7] + (size_t)l * DM * INC, INC, wl, DM, (r / 40) * 64, n0, nd, tile); }
        else if ((r -= 640) < 256) { transpose_tile(P.in[16] + (size_t)l * DM * DM, DM, wl + W_IN_E, DM, (r / 16) * 64, (r % 16) * 64, (r % 16) * 64, tile); }
        else if ((r -= 256) < 1408) { const int n0 = (r % 88) * 64; const int up = n0 >= FFN; const int j0 = up ? n0 - FFN : n0; const int nd = 256 * (j0 / 128) + (up ? 128 : 0) + (j0 % 128);
          transpose_tile(P.in[18] + (size_t)l * DM * 2 * FFN, 2 * FFN, wl + W_IN_E + W_OUT_E, DM, (r / 88) * 64, n0, nd, tile); }
        else if ((r -= 1408) < 704) { transpose_tile(P.in[19] + (size_t)l * FFN * DM, DM, wl + W_IN_E + W_OUT_E + W_GU_E, FFN, (r / 16) * 64, (r % 16) * 64, (r % 16) * 64, tile); }
        else { }
      } else {
        for (int i = tid; i < 64 * 16; i += NTHREADS) { const int pos = i >> 4, f = i & 15; const float inv = 1.0f / powf(10000.0f, (float)f / 16.0f); const float ang = (float)pos * inv;
          ROPE[i] = cosf(ang); ROPE[1024 + i] = sinf(ang); }
        if (tid < DEPTH) { const int l = tid; float d1 = 0.f, d2 = 0.f;
          for (int i = 0; i < 64; ++i) { d1 += P.in[8][l * 64 + i] * P.in[9][l * 64 + i]; d2 += P.in[10][l * 64 + i] * P.in[11][l * 64 + i]; }
          const float li = 0.8f - 0.6f * expf(-0.3f * (float)l);
          LAMV[l * 2] = expf(d1) - expf(d2) + li; LAMV[l * 2 + 1] = 1.f - li; }
      }
    }
  }
  for (int i = bid * NTHREADS + tid; i < NFUSE * MALL; i += G * NTHREADS) { const f32x4 m1 = {-1.f, -1.f, -1.f, -1.f}; f32x4* sp = (f32x4*)XCH + i;
    asm volatile("global_store_dwordx4 %0, %1, off sc1" :: "v"(sp), "v"(m1) : "memory"); }
  for (int i = bid * NTHREADS + tid; i < 2 * DEPTH * 128; i += G * NTHREADS) __hip_atomic_store(SKC + (size_t)i * 64, 0u, __ATOMIC_RELAXED, __HIP_MEMORY_SCOPE_AGENT);
  for (int i = bid * NTHREADS + tid; i < 2 * DM; i += G * NTHREADS) ((float*)CNT)[i] = 0.f;
  const bool fuse_ok = (G == 256);
  unsigned* BARC = (unsigned*)(ws + WS_BAR); unsigned nbar = 0;
  if (bid == 0 && tid == 0) __hip_atomic_store(BARC, 0u, __ATOMIC_RELAXED, __HIP_MEMORY_SCOPE_AGENT);
  grid.sync();

  for (int l = 0; l < DEPTH; ++l) {
    const bool last = (l == DEPTH - 1);
    const float* modl = MOD + (size_t)l * 33 * NMOD * DM;
    const bf16_t* wl = WB + (size_t)l * W_LAYER_E;
    if (l == 0) { norm_phase<true>(x_in, ctx_in, XB, P.in[6] + l * DM, modl, 0, 1, ACT, MALL); grid_bar(BARC, (unsigned)G * (++nbar)); }
    else if (!fuse_ok) { norm_phase<false>(nullptr, nullptr, XB, P.in[6] + l * DM, modl, 0, 1, ACT, MALL); grid_bar(BARC, (unsigned)G * (++nbar)); }
    for (int rep = 0; rep < ((DUP & 2) ? 2 : 1); ++rep)
    if constexpr (EN(2)) { pg8::Gemm g{ACT, wl, DM}; pg8::Sched S; S.init(INC / 256, MCTX / 256, last ? 2 : 0, last ? 4 : INC / 256, G, bid, DM / 64);
      pg8::EpiProj E{PROJ, ROPE, ROPE + 1024};
      pg8::gemm_phase<pg8::EpiProj>((LAS unsigned char*)lds, g, S, E); }
    grid_bar(BARC, (unsigned)G * (++nbar));
    for (int rep = 0; rep < ((DUP & 1) ? 2 : 1); ++rep)
    if constexpr (EN(3)) { const float lam = LAMV[l * 2], post = LAMV[l * 2 + 1]; const float* gsub = P.in[12] + l * 128;
      const int nAttL = NB * 4 * 16, nAttC = last ? 0 : NB * 4 * 2, nMix = last ? MLAT / 64 : MALL / 64;
      const int nItems = nAttL + nAttC + nMix;
      for (int it = bid; it < nItems; it += G) {
        if (it < nAttL + nAttC) { int bh, qb, qrow0, lrow0, NT;
          if (it < nAttL) {
            if (G == 256) { const int j = it & 255, k = it >> 8, xcd = j & 7, slot = j >> 3; bh = k * 16 + xcd * 2 + (slot >> 4); qb = slot & 15; } else { bh = it >> 4; qb = it & 15; }
            qrow0 = (bh >> 2) * SEQ + qb * 128; lrow0 = (bh >> 2) * SEQ; NT = 36;
          } else { const int id = it - nAttL; bh = id >> 1; qb = id & 1; qrow0 = MLAT + (bh >> 2) * CTXL + qb * 128; lrow0 = 0; NT = 4; }
          att::attn_item(PROJ, ACT, qrow0, bh & 3, MLAT + (bh >> 2) * CTXL, lrow0, NT, lam, post, gsub, (char*)lds);
        } else { const int tile = it - nAttL - nAttC; int rb, p0, Ls;
          if (tile < MLAT / 64) { rb = tile * 64; p0 = (tile & 31) * 64; Ls = SEQ; } else { rb = tile * 64; p0 = (tile & 3) * 64; Ls = CTXL; }
          for (int rep2 = 0; rep2 < ((DUP & 32) ? 2 : 1); ++rep2)
          mixer_item(PROJ, ACT, rb, p0, Ls, P.in[13] + l * 768, P.in[15] + l * 256, (char*)lds);
        }
      }
    }
    grid_bar(BARC, (unsigned)G * (++nbar));
    if constexpr (EN(4)) { pg8::Gemm g{ACT, wl + W_IN_E, DM}; pg8::Sched S; S.init(DM / 256, last ? 0 : MCTX / 256, 0, DM / 256, G, bid, DM / 64, fuse_ok);
      pg8::EpiResNorm E{XB, modl + 2 * DM, fuse_ok, H2, P.in[17] + l * DM, modl, 3, 4, XCH + (size_t)(2 * l) * MALL * 4, (LAS unsigned char*)lds + pg8::STAGE_BYTES, nullptr, NMOD * DM, SLAB, SKC + (size_t)(0 * DEPTH + l) * 128 * 64};
      pg8::gemm_phase<pg8::EpiResNorm>((LAS unsigned char*)lds, g, S, E); }
    grid_bar(BARC, (unsigned)G * (++nbar));
    if (!fuse_ok) { norm_phase<false>(nullptr, nullptr, XB, P.in[17] + l * DM, modl, 3, 4, H2, last ? MLAT : MALL); grid_bar(BARC, (unsigned)G * (++nbar)); }
    for (int rep = 0; rep < ((DUP & 2) ? 2 : 1); ++rep)
    if constexpr (EN(6)) { pg8::Gemm g{H2, wl + W_IN_E + W_OUT_E, DM}; pg8::Sched S; S.init(2 * FFN / 256, last ? 0 : MCTX / 256, 0, 2 * FFN / 256, G, bid, DM / 64);
      pg8::EpiSwi E{PROJ};
      pg8::gemm_phase<pg8::EpiSwi>((LAS unsigned char*)lds, g, S, E); }
    grid_bar(BARC, (unsigned)G * (++nbar));
    if constexpr (EN(7)) { pg8::Gemm g{PROJ, wl + W_IN_E + W_OUT_E + W_GU_E, FFN}; pg8::Sched S; S.init(DM / 256, last ? 0 : MCTX / 256, 0, DM / 256, G, bid, FFN / 64, fuse_ok);
      const int ln = last ? l : l + 1;
      const bool fin = last && fuse_ok;
      pg8::EpiResNorm E{XB, modl + 5 * DM, fuse_ok, ACT, fin ? P.in[20] : P.in[6] + ln * DM, fin ? (const float*)CNT : MOD + (size_t)ln * 33 * NMOD * DM, 0, 1, XCH + (size_t)(2 * l + 1) * MALL * 4, (LAS unsigned char*)lds + pg8::STAGE_BYTES, fin ? P.out : nullptr, fin ? 0 : NMOD * DM, SLAB, SKC + (size_t)(1 * DEPTH + l) * 128 * 64};
      pg8::gemm_phase<pg8::EpiResNorm>((LAS unsigned char*)lds, g, S, E); }
    grid_bar(BARC, (unsigned)G * (++nbar));
  }
  if (!fuse_ok) final_norm(XB, P.out, P.in[20]);
}

extern "C" void kernel_launch(void* const* d_in, const int* in_sizes, int n_in, void* d_out, int out_size, void* d_ws, size_t ws_size, hipStream_t stream) {
  static int grid_blocks = 0;
  if (grid_blocks == 0) {
    if (n_in != 21 || out_size != MLAT * DM || ws_size < WS_END) { fprintf(stderr, "kernel_launch: unexpected shapes n_in %d out %d ws %zu (need %zu)\n", n_in, out_size, ws_size, (size_t)WS_END); grid_blocks = -1; return; }
    int dev = 0, cus = 0, per_cu = 0;
    hipGetDevice(&dev); hipDeviceGetAttribute(&cus, hipDeviceAttributeMultiprocessorCount, dev);
    if (hipFuncSetAttribute((const void*)fwd_megakernel, hipFuncAttributeMaxDynamicSharedMemorySize, LDS_BYTES) != hipSuccess) { fprintf(stderr, "kernel_launch: hipFuncSetAttribute failed\n"); grid_blocks = -1; return; }
    hipOccupancyMaxActiveBlocksPerMultiprocessor(&per_cu, (const void*)fwd_megakernel, NTHREADS, LDS_BYTES);
    if (per_cu < 1) { fprintf(stderr, "kernel_launch: occupancy query says %d blocks per CU\n", per_cu); per_cu = 1; }
    grid_blocks = cus * 1;
    (void)hipGetLastError();
  }
  if (grid_blocks < 0) return;
  Params p{};
  for (int i = 0; i < 21; ++i) p.in[i] = (const float*)d_in[i];
  p.out = (float*)d_out; p.ws = (unsigned char*)d_ws;
  void* args[] = {&p};
  hipError_t e = hipLaunchCooperativeKernel((const void*)fwd_megakernel, dim3(grid_blocks), dim3(NTHREADS), args, LDS_BYTES, stream);
  if (e != hipSuccess) fprintf(stderr, "cooperative launch failed: %s (grid %d)\n", hipGetErrorString(e), grid_blocks);
}
```

```cpp
#include <hip/hip_runtime.h>
#include <hip/hip_cooperative_groups.h>
#include <cstdio>
#include <cstdint>
namespace cg = cooperative_groups;

#define LAS __attribute__((address_space(3)))
typedef unsigned short bf16_t;
typedef short bf16x8 __attribute__((ext_vector_type(8)));
typedef short s16x4 __attribute__((ext_vector_type(4)));
typedef float f32x4 __attribute__((ext_vector_type(4)));
typedef float f32x16 __attribute__((ext_vector_type(16)));
typedef unsigned u32x4 __attribute__((ext_vector_type(4)));
typedef unsigned u32x2 __attribute__((ext_vector_type(2)));

constexpr int DM = 1024, NB = 32, SEQ = 2048, DEPTH = 4, CTXL = 256;
constexpr int MLAT = NB * SEQ, MCTX = NB * CTXL, MALL = MLAT + MCTX;
constexpr int INC = 2560, FFN = 2816, NMOD = 6;
constexpr float EPS = 1e-6f;
constexpr int NTHREADS = 512;
constexpr int LDS_BYTES = 152 * 1024;

constexpr size_t WS_XB   = 0;
constexpr size_t WS_ACT  = WS_XB + (size_t)MALL * DM * 2;
constexpr size_t WS_PROJ = WS_ACT + (size_t)MALL * DM * 2;
constexpr size_t WS_W    = WS_PROJ + (size_t)MALL * FFN * 2;
constexpr size_t W_IN_E = (size_t)INC * DM, W_OUT_E = (size_t)DM * DM, W_GU_E = (size_t)2 * FFN * DM, W_DN_E = (size_t)DM * FFN;
constexpr size_t W_LAYER_E = W_IN_E + W_OUT_E + W_GU_E + W_DN_E;
constexpr size_t WS_WPOOL = WS_W + W_LAYER_E * 2 * DEPTH;
constexpr size_t WS_MOD  = WS_WPOOL + (size_t)DEPTH * 4 * 64 * 64 * 2;
constexpr size_t WS_ROPE = WS_MOD + (size_t)DEPTH * 33 * NMOD * DM * 4;
constexpr size_t WS_LAM  = WS_ROPE + 2 * 64 * 16 * 4;
constexpr size_t WS_BAR  = WS_LAM + 256;
constexpr size_t WS_H2   = WS_BAR + 256;
constexpr int    NFUSE   = 2 * DEPTH;
constexpr size_t WS_XCH  = WS_H2 + (size_t)MALL * DM * 2;
constexpr size_t WS_CNT  = WS_XCH + (size_t)NFUSE * MALL * 4 * 4;
constexpr size_t WS_END  = WS_CNT + (size_t)NFUSE * (MALL / 256) * 256;

#ifndef ONLY
#define ONLY -1
#endif
#define EN(n) (ONLY < 0 || ONLY == (n))
#ifndef DUP
#define DUP 0
#endif
struct Params { const float* in[21]; float* out; unsigned char* ws; };

__device__ __forceinline__ int opaque_tid() { int t = threadIdx.x; asm volatile("" : "+v"(t)); return t; }
__device__ __forceinline__ float bperm_xor(float v, int m, int lane) { return __builtin_bit_cast(float, __builtin_amdgcn_ds_bpermute((lane ^ m) << 2, __builtin_bit_cast(int, v))); }
__device__ __forceinline__ unsigned cvt_pk_bf16(float lo, float hi) { unsigned r; asm volatile("v_cvt_pk_bf16_f32 %0, %1, %2" : "=v"(r) : "v"(lo), "v"(hi)); return r; }

namespace pg8 {
constexpr int BM = 256, BK = 64, HALF = 128, HTB = HALF * BK * 2, STAGE_BYTES = 8 * HTB;
__device__ __forceinline__ int lds_byte(int r, int c) { const int st = (r >> 4) * 2 + (c >> 5), rr = r & 15, cc = c & 31, ob = rr * 64 + cc * 2; return st * 1024 + (ob ^ (((ob >> 9) & 1) << 5)); }
__device__ __forceinline__ void stage_rc(int b, int& R, int& C) { const int st = b / 1024, sb = b % 1024, swz = sb ^ (((sb >> 9) & 1) << 5); R = (st >> 1) * 16 + swz / 64; C = (st & 1) * 32 + (swz % 64) / 2; }
__device__ __forceinline__ int perm32(int rho) { const int n = rho >> 4, i = rho & 15; return 8 * (i >> 2) + 4 * n + (i & 3); }
struct Unit { int pm, pn; };
struct Gemm { const bf16_t* A; const bf16_t* Bt; int K; };

struct Sched {
    int nN, nLat, nTot, G, c, cpn0, cnN;
    __device__ void init(int nN_, int nCtxRows, int cpn0_, int cnN_, int G_, int c_) { nN = nN_; nLat = 256 * nN_; cpn0 = cpn0_; cnN = cnN_; nTot = nLat + nCtxRows * cnN_; G = G_; c = c_; }
    __device__ __forceinline__ bool next(int i, Unit& u) const {
        const int L = i * G + c; if (L >= nTot) return false;
        if (L < nLat) {
            const int q = nLat >> 3; const int wgid = (L & 7) * q + (L >> 3);
            const int nig = 8 * nN, gid = wgid / nig, rem = wgid % nig;
            u.pm = gid * 8 + (rem & 7); u.pn = rem >> 3;
        } else { const int Lc = L - nLat; u.pm = 256 + Lc / cnN; u.pn = cpn0 + Lc % cnN; }
        return true;
    }
};

template <class Epi>
__device__ __forceinline__ void gemm_phase(LAS unsigned char* lds, const Gemm g, const Sched& S, const Epi& E) {
    const int tid = opaque_tid(), wid = __builtin_amdgcn_readfirstlane(tid >> 6), lane = tid & 63, wr = wid >> 2, wc = wid & 3, fr = lane & 15, fq = lane >> 4;
    const int K = g.K, nt = K / BK;
    unsigned voffA[2], voffB[2];
#pragma unroll
    for (int i = 0; i < 2; ++i) { int R, C; stage_rc(tid * 16 + i * 8192, R, C); const int Rb = Epi::PERM ? ((R & ~31) + perm32(R & 31)) : R;
        voffA[i] = (unsigned)(R * K + C) * 2u; voffB[i] = (unsigned)(Rb * K + C) * 2u; }
    const size_t kstep = (size_t)(BK * 2);
    const size_t hstep = (size_t)HALF * K * 2;
    const size_t tstep = 2 * hstep;
    const unsigned ldsw = (unsigned)wid * 1024u;
    const int aoff = lds_byte(wr * 64 + fr, fq * 8), boff = lds_byte(wc * 32 + fr, fq * 8);
#define PG8_SA(b, h) (((b) * 2 + (h)) * HTB)
#define PG8_SB(b, h) ((4 + (b) * 2 + (h)) * HTB)
#define PG8_STAGE(bufoff, gbase, voff) do { _Pragma("unroll") for (int _i = 0; _i < 2; ++_i) \
        __builtin_amdgcn_global_load_lds((const unsigned*)((const char*)(gbase) + (voff)[_i]), (LAS unsigned*)(lds + (bufoff) + ldsw + _i * 8192), 16, 0, 0); } while (0)
#define PG8_LDA(dst, b, h) do { _Pragma("unroll") for (int m = 0; m < 4; ++m) _Pragma("unroll") for (int k = 0; k < 2; ++k) dst[m][k] = *(const LAS bf16x8*)(lds + PG8_SA(b, h) + aoff + m * 2048 + k * 1024); } while (0)
#define PG8_LDB(dst, b, h) do { _Pragma("unroll") for (int n = 0; n < 2; ++n) _Pragma("unroll") for (int k = 0; k < 2; ++k) dst[n][k] = *(const LAS bf16x8*)(lds + PG8_SB(b, h) + boff + n * 2048 + k * 1024); } while (0)
#define PG8_MMA(ai, bj, At, Bt) do { __builtin_amdgcn_s_setprio(1); _Pragma("unroll") for (int m = 0; m < 4; ++m) _Pragma("unroll") for (int n = 0; n < 2; ++n) _Pragma("unroll") for (int k = 0; k < 2; ++k) \
        acc[ai][bj][m][n] = __builtin_amdgcn_mfma_f32_16x16x32_bf16(Bt[n][k], At[m][k], acc[ai][bj][m][n], 0, 0, 0); __builtin_amdgcn_s_setprio(0); } while (0)
#define PG8_WAIT_V(n) asm volatile("s_waitcnt vmcnt(" #n ")" ::: "memory")
#define PG8_WAIT_L(n) asm volatile("s_waitcnt lgkmcnt(" #n ")" ::: "memory")
#define PG8_BAR __builtin_amdgcn_s_barrier()
#define PG8_SCHED __builtin_amdgcn_sched_barrier(0)
    Unit cur, nxt; int ui = 0;
    if (!S.next(0, cur)) return;
    f32x4 acc[2][2][4][2];
#pragma unroll
    for (int a = 0; a < 2; ++a)
#pragma unroll
        for (int b = 0; b < 2; ++b)
#pragma unroll
            for (int m = 0; m < 4; ++m)
#pragma unroll
                for (int n = 0; n < 2; ++n) acc[a][b][m][n] = (f32x4){0.f, 0.f, 0.f, 0.f};
    bf16x8 At[4][2], B0[2][2], B1[2][2];
    const char* cA = (const char*)g.A + (size_t)cur.pm * tstep; const char* cB = (const char*)g.Bt + (size_t)cur.pn * tstep;
    PG8_STAGE(PG8_SB(0, 0), cB, voffB); PG8_STAGE(PG8_SB(0, 1), cB + hstep, voffB); PG8_STAGE(PG8_SA(0, 0), cA, voffA); PG8_STAGE(PG8_SA(0, 1), cA + hstep, voffA);
    if (wr == 1) PG8_BAR;
    PG8_WAIT_V(2); PG8_BAR;
    PG8_STAGE(PG8_SB(1, 0), cB + kstep, voffB); PG8_STAGE(PG8_SA(1, 0), cA + kstep, voffA); PG8_STAGE(PG8_SB(1, 1), cB + hstep + kstep, voffB);
    PG8_WAIT_V(6); PG8_BAR;
    for (;;) {
        const bool has_next = S.next(ui + 1, nxt);
        const char* nA = has_next ? (const char*)g.A + (size_t)nxt.pm * tstep : cA; const char* nB = has_next ? (const char*)g.Bt + (size_t)nxt.pn * tstep : cB;
        for (int t = 0; t < nt; t += 2) {
            const bool last = (t == nt - 2);
            const char* a1 = cA + (size_t)(t + 1) * kstep;
            const char* a2 = last ? nA : cA + (size_t)(t + 2) * kstep; const char* b2 = last ? nB : cB + (size_t)(t + 2) * kstep;
            const char* a3 = a2 + kstep; const char* b3 = b2 + kstep;
            PG8_LDB(B0, 0, 0); PG8_LDB(B1, 0, 1); PG8_SCHED; PG8_LDA(At, 0, 0); PG8_STAGE(PG8_SA(1, 1), a1 + hstep, voffA);
            PG8_WAIT_V(8); PG8_WAIT_L(0); PG8_BAR; PG8_MMA(0, 0, At, B0); PG8_MMA(0, 1, At, B1); PG8_BAR; PG8_SCHED;
            PG8_LDA(At, 0, 1); PG8_STAGE(PG8_SB(0, 0), b2, voffB); PG8_STAGE(PG8_SB(0, 1), b2 + hstep, voffB); PG8_STAGE(PG8_SA(0, 0), a2, voffA);
            PG8_WAIT_V(8); PG8_WAIT_L(0); PG8_BAR; PG8_MMA(1, 0, At, B0); PG8_MMA(1, 1, At, B1); PG8_BAR; PG8_SCHED;
            PG8_LDB(B0, 1, 0); PG8_LDB(B1, 1, 1); PG8_SCHED; PG8_LDA(At, 1, 0); PG8_STAGE(PG8_SA(0, 1), a2 + hstep, voffA);
            PG8_WAIT_V(8); PG8_WAIT_L(0); PG8_BAR; PG8_MMA(0, 0, At, B0); PG8_MMA(0, 1, At, B1); PG8_BAR; PG8_SCHED;
            PG8_LDA(At, 1, 1); PG8_STAGE(PG8_SB(1, 0), b3, voffB); PG8_STAGE(PG8_SB(1, 1), b3 + hstep, voffB); PG8_STAGE(PG8_SA(1, 0), a3, voffA);
            PG8_WAIT_V(8); PG8_WAIT_L(0); PG8_BAR; PG8_MMA(1, 0, At, B0); PG8_MMA(1, 1, At, B1); PG8_BAR; PG8_SCHED;
        }
        if (wr == 0) PG8_BAR;
        E(acc, cur, wr, wc, fr, fq);
        if (!has_next) break;
#pragma unroll
        for (int a = 0; a < 2; ++a)
#pragma unroll
            for (int b = 0; b < 2; ++b)
#pragma unroll
                for (int m = 0; m < 4; ++m)
#pragma unroll
                    for (int n = 0; n < 2; ++n) acc[a][b][m][n] = (f32x4){0.f, 0.f, 0.f, 0.f};
        cur = nxt; cA = nA; cB = nB; ++ui;
        if (wr == 1) PG8_BAR;
    }
    PG8_WAIT_V(0);
    PG8_BAR;
#undef PG8_SA
#undef PG8_SB
#undef PG8_STAGE
#undef PG8_LDA
#undef PG8_LDB
#undef PG8_MMA
#undef PG8_WAIT_V
#undef PG8_WAIT_L
#undef PG8_BAR
#undef PG8_SCHED
}

struct EpiProj {
    static constexpr bool PERM = true;
    bf16_t* O; const float* cosT; const float* sinT;
    __device__ __forceinline__ void operator()(const f32x4 (&acc)[2][2][4][2], const Unit& u, int wr, int wc, int fr, int fq) const {
        const int row0 = u.pm * BM + wr * 64 + fr, col0 = u.pn * BM + wc * 32 + 8 * fq;
        const bool rope = (u.pm < 256) && (u.pn < 4);
        const float sgn = (fq & 2) ? 1.f : -1.f; const int lane_ = (fq << 4) | fr;
#pragma unroll
        for (int ai = 0; ai < 2; ++ai)
#pragma unroll
            for (int m = 0; m < 4; ++m) {
                const int r = row0 + ai * HALF + m * 16;
                f32x4 c0 = {1.f, 1.f, 1.f, 1.f}, c1 = c0, s0 = {0.f, 0.f, 0.f, 0.f}, s1 = s0;
                if (rope) { const int p = r & (SEQ - 1); const int pos = (wc & 1) ? (p & 63) : (p >> 6); const int f0 = 8 * (fq & 1);
                    c0 = *(const f32x4*)(cosT + pos * 16 + f0); c1 = *(const f32x4*)(cosT + pos * 16 + f0 + 4);
                    s0 = *(const f32x4*)(sinT + pos * 16 + f0); s1 = *(const f32x4*)(sinT + pos * 16 + f0 + 4); }
                if (u.pn == 7 || u.pn == 8) {
                    const f32x4 u0 = acc[ai][0][m][0] * acc[ai][1][m][0], u1 = acc[ai][0][m][1] * acc[ai][1][m][1];
                    u32x4 w; w.x = cvt_pk_bf16(u0[0], u0[1]); w.y = cvt_pk_bf16(u0[2], u0[3]); w.z = cvt_pk_bf16(u1[0], u1[1]); w.w = cvt_pk_bf16(u1[2], u1[3]);
                    *(u32x4*)(O + (size_t)r * INC + 1792 + (u.pn - 7) * HALF + wc * 32 + 8 * fq) = w; continue; }
                bf16_t* rowp = O + (size_t)r * INC + col0;
#pragma unroll
                for (int bj = 0; bj < 2; ++bj) { f32x4 v0 = acc[ai][bj][m][0], v1 = acc[ai][bj][m][1];
                    if (rope) {
#pragma unroll
                        for (int j = 0; j < 4; ++j) { const float p0 = bperm_xor(v0[j], 32, lane_), p1 = bperm_xor(v1[j], 32, lane_);
                            v0[j] = v0[j] * c0[j] + sgn * p0 * s0[j]; v1[j] = v1[j] * c1[j] + sgn * p1 * s1[j]; } }
                    u32x4 w; w.x = cvt_pk_bf16(v0[0], v0[1]); w.y = cvt_pk_bf16(v0[2], v0[3]); w.z = cvt_pk_bf16(v1[0], v1[1]); w.w = cvt_pk_bf16(v1[2], v1[3]);
                    *(u32x4*)(rowp + bj * HALF) = w; } }
    }
};
struct EpiResB {
    static constexpr bool PERM = true;
    bf16_t* X; const float* gate;
    __device__ __forceinline__ void operator()(const f32x4 (&acc)[2][2][4][2], const Unit& u, int wr, int wc, int fr, int fq) const {
        const int b = (u.pm < 256) ? (u.pm >> 3) : 32;
        const int row0 = u.pm * BM + wr * 64 + fr, col0 = u.pn * BM + wc * 32 + 8 * fq;
        f32x4 gv[2][2];
#pragma unroll
        for (int bj = 0; bj < 2; ++bj)
#pragma unroll
            for (int n = 0; n < 2; ++n) gv[bj][n] = *(const f32x4*)(gate + (size_t)b * (NMOD * DM) + col0 + bj * HALF + n * 4);
#pragma unroll
        for (int ai = 0; ai < 2; ++ai) {
            u32x4 xv[4][2];
#pragma unroll
            for (int m = 0; m < 4; ++m)
#pragma unroll
                for (int bj = 0; bj < 2; ++bj) xv[m][bj] = *(const u32x4*)(X + (size_t)(row0 + ai * HALF + m * 16) * DM + col0 + bj * HALF);
#pragma unroll
            for (int m = 0; m < 4; ++m)
#pragma unroll
                for (int bj = 0; bj < 2; ++bj) { const u32x4 xw = xv[m][bj]; const f32x4 a0 = acc[ai][bj][m][0] * gv[bj][0], a1 = acc[ai][bj][m][1] * gv[bj][1];
                    u32x4 w;
                    w.x = cvt_pk_bf16(__uint_as_float(xw.x << 16) + a0[0], __uint_as_float(xw.x & 0xffff0000u) + a0[1]);
                    w.y = cvt_pk_bf16(__uint_as_float(xw.y << 16) + a0[2], __uint_as_float(xw.y & 0xffff0000u) + a0[3]);
                    w.z = cvt_pk_bf16(__uint_as_float(xw.z << 16) + a1[0], __uint_as_float(xw.z & 0xffff0000u) + a1[1]);
                    w.w = cvt_pk_bf16(__uint_as_float(xw.w << 16) + a1[2], __uint_as_float(xw.w & 0xffff0000u) + a1[3]);
                    *(u32x4*)(X + (size_t)(row0 + ai * HALF + m * 16) * DM + col0 + bj * HALF) = w; } }
    }
};
struct EpiResNorm {
    static constexpr bool PERM = true;
    bf16_t* X; const float* gate; bool fuse;
    bf16_t* H; const float* gw; const float* modn; int shi, sci;
    float* xch; LAS unsigned char* tab;
    float* F; int mstride;
    __device__ __forceinline__ void operator()(f32x4 (&acc)[2][2][4][2], const Unit& u, int wr, int wc, int fr, int fq) const {
        const int b = (u.pm < 256) ? (u.pm >> 3) : 32;
        const int row0 = u.pm * BM + wr * 64 + fr, col0 = u.pn * BM + wc * 32 + 8 * fq;
        { f32x4 gv[2][2];
#pragma unroll
          for (int bj = 0; bj < 2; ++bj)
#pragma unroll
            for (int n = 0; n < 2; ++n) gv[bj][n] = *(const f32x4*)(gate + (size_t)b * (NMOD * DM) + col0 + bj * HALF + n * 4);
#pragma unroll
          for (int ai = 0; ai < 2; ++ai) {
            u32x4 xv[4][2];
#pragma unroll
            for (int m = 0; m < 4; ++m)
#pragma unroll
                for (int bj = 0; bj < 2; ++bj) xv[m][bj] = *(const u32x4*)(X + (size_t)(row0 + ai * HALF + m * 16) * DM + col0 + bj * HALF);
#pragma unroll
            for (int m = 0; m < 4; ++m)
#pragma unroll
                for (int bj = 0; bj < 2; ++bj) { const u32x4 xw = xv[m][bj]; f32x4 a0 = acc[ai][bj][m][0] * gv[bj][0], a1 = acc[ai][bj][m][1] * gv[bj][1];
                    a0[0] += __uint_as_float(xw.x << 16); a0[1] += __uint_as_float(xw.x & 0xffff0000u); a0[2] += __uint_as_float(xw.y << 16); a0[3] += __uint_as_float(xw.y & 0xffff0000u);
                    a1[0] += __uint_as_float(xw.z << 16); a1[1] += __uint_as_float(xw.z & 0xffff0000u); a1[2] += __uint_as_float(xw.w << 16); a1[3] += __uint_as_float(xw.w & 0xffff0000u);
                    acc[ai][bj][m][0] = a0; acc[ai][bj][m][1] = a1; } } }
        const int tid = threadIdx.x;
        LAS float* Pt = (LAS float*)tab; LAS float* St = (LAS float*)(tab + 4096);
        if (fuse) {
#pragma unroll
            for (int ai = 0; ai < 2; ++ai)
#pragma unroll
                for (int m = 0; m < 4; ++m) { float q = 0.f;
#pragma unroll
                    for (int bj = 0; bj < 2; ++bj)
#pragma unroll
                        for (int n = 0; n < 2; ++n) { const f32x4 x = acc[ai][bj][m][n]; q += (x[0] * x[0] + x[1] * x[1]) + (x[2] * x[2] + x[3] * x[3]); }
                    q += bperm_xor(q, 16, (fq << 4) | fr); q += bperm_xor(q, 32, (fq << 4) | fr);
                    if (fq == 0) Pt[(ai * HALF + wr * 64 + m * 16 + fr) * 4 + wc] = q; }
            asm volatile("s_waitcnt lgkmcnt(0)" ::: "memory"); __builtin_amdgcn_s_barrier(); asm volatile("" ::: "memory");
            if (tid < 256) { const float t = (Pt[tid * 4 + 0] + Pt[tid * 4 + 1]) + (Pt[tid * 4 + 2] + Pt[tid * 4 + 3]);
                __hip_atomic_store(xch + ((size_t)u.pm * BM + tid) * 4 + u.pn, t, __ATOMIC_RELAXED, __HIP_MEMORY_SCOPE_AGENT); }
        }
#pragma unroll
        for (int ai = 0; ai < 2; ++ai)
#pragma unroll
            for (int m = 0; m < 4; ++m)
#pragma unroll
                for (int bj = 0; bj < 2; ++bj) { const f32x4 a0 = acc[ai][bj][m][0], a1 = acc[ai][bj][m][1];
                    u32x4 w; w.x = cvt_pk_bf16(a0[0], a0[1]); w.y = cvt_pk_bf16(a0[2], a0[3]); w.z = cvt_pk_bf16(a1[0], a1[1]); w.w = cvt_pk_bf16(a1[2], a1[3]);
                    *(u32x4*)(X + (size_t)(row0 + ai * HALF + m * 16) * DM + col0 + bj * HALF) = w; }
        if (!fuse) return;
        if (tid < 256) { const float* sl = xch + ((size_t)u.pm * BM + tid) * 4; f32x4 v;
            for (int spin = 0; spin < (1 << 22); ++spin) {
                asm volatile("global_load_dwordx4 %0, %1, off sc1\n\ts_waitcnt vmcnt(0)" : "=&v"(v) : "v"(sl) : "memory");
                const bool ok = (v[0] >= 0.f) && (v[1] >= 0.f) && (v[2] >= 0.f) && (v[3] >= 0.f);
                if (__all(ok)) break;
                __builtin_amdgcn_s_sleep(1); }
            St[tid] = rsqrtf(((v[0] + v[1]) + (v[2] + v[3])) * (1.f / DM) + EPS); }
        asm volatile("s_waitcnt vmcnt(0) lgkmcnt(0)" ::: "memory"); __builtin_amdgcn_s_barrier(); asm volatile("" ::: "memory");
        const float* mb = modn + (size_t)b * mstride;
#pragma unroll
        for (int bj = 0; bj < 2; ++bj) { f32x4 gg[2], sc[2], sh[2];
#pragma unroll
            for (int n = 0; n < 2; ++n) { const int c = col0 + bj * HALF + n * 4; gg[n] = *(const f32x4*)(gw + c); sc[n] = *(const f32x4*)(mb + sci * DM + c) + 1.f; sh[n] = *(const f32x4*)(mb + shi * DM + c); gg[n] = gg[n] * sc[n]; }
#pragma unroll
            for (int ai = 0; ai < 2; ++ai)
#pragma unroll
                for (int m = 0; m < 4; ++m) { const float rs = St[ai * HALF + wr * 64 + m * 16 + fr];
                    const f32x4 y0 = (acc[ai][bj][m][0] * rs) * gg[0] + sh[0], y1 = (acc[ai][bj][m][1] * rs) * gg[1] + sh[1];
                    if (F) { float* op = F + (size_t)(row0 + ai * HALF + m * 16) * DM + col0 + bj * HALF; *(f32x4*)op = y0; *(f32x4*)(op + 4) = y1; }
                    else { u32x4 w; w.x = cvt_pk_bf16(y0[0], y0[1]); w.y = cvt_pk_bf16(y0[2], y0[3]); w.z = cvt_pk_bf16(y1[0], y1[1]); w.w = cvt_pk_bf16(y1[2], y1[3]);
                        *(u32x4*)(H + (size_t)(row0 + ai * HALF + m * 16) * DM + col0 + bj * HALF) = w; } } }
    }
};
struct EpiSwi {
    static constexpr bool PERM = true;
    bf16_t* O;
    __device__ __forceinline__ void operator()(const f32x4 (&acc)[2][2][4][2], const Unit& u, int wr, int wc, int fr, int fq) const {
        const int row0 = u.pm * BM + wr * 64 + fr, col0 = u.pn * HALF + wc * 32 + 8 * fq;
#pragma unroll
        for (int ai = 0; ai < 2; ++ai)
#pragma unroll
            for (int m = 0; m < 4; ++m) { float h[8];
#pragma unroll
                for (int n = 0; n < 2; ++n)
#pragma unroll
                    for (int j = 0; j < 4; ++j) { const float gt = acc[ai][0][m][n][j], up = acc[ai][1][m][n][j];
                        h[n * 4 + j] = gt * __builtin_amdgcn_rcpf(1.f + __builtin_amdgcn_exp2f(-1.4426950408889634f * gt)) * up; }
                u32x4 w; w.x = cvt_pk_bf16(h[0], h[1]); w.y = cvt_pk_bf16(h[2], h[3]); w.z = cvt_pk_bf16(h[4], h[5]); w.w = cvt_pk_bf16(h[6], h[7]);
                *(u32x4*)(O + (size_t)(row0 + ai * HALF + m * 16) * FFN + col0) = w; }
    }
};
}

namespace att {
constexpr int KVBLK = 64;
constexpr float SCALE = 0.125f, THR = 8.f;
constexpr int SHM_V = KVBLK * 128 * 2, SHM_K = KVBLK * 128 * 2;
constexpr int OX_STRIDE = 144;
constexpr int OX_BYTES = 128 * OX_STRIDE * 4;
constexpr int WSCR_OFF = 2 * OX_BYTES;
#define KSWZ(row, colB) ((row) * 256 + ((colB) ^ (((row) & 15) << 4)))
#define SBAR() __builtin_amdgcn_sched_barrier(0)
__device__ __forceinline__ int crow(int r, int hi) { return (r & 3) + 8 * (r >> 2) + 4 * hi; }

__device__ __forceinline__ void partialSM(f32x16& p0, f32x16& p1, float& m_reg, float& mn, float& alpha) {
  constexpr float C = SCALE * 1.4426950408889634f;
  float pmax = p0[0];
#pragma unroll
  for (int r = 1; r < 16; ++r) pmax = fmaxf(pmax, p0[r]);
#pragma unroll
  for (int r = 0; r < 16; ++r) pmax = fmaxf(pmax, p1[r]);
  { auto rr = __builtin_amdgcn_permlane32_swap(__float_as_uint(pmax), __float_as_uint(pmax), false, false);
    pmax = fmaxf(__uint_as_float(rr[0]), __uint_as_float(rr[1])); }
  if (__builtin_expect(__all(pmax - m_reg <= THR / SCALE), 1)) { mn = m_reg; alpha = 1.f; }
  else { mn = fmaxf(m_reg, pmax); alpha = __builtin_amdgcn_exp2f((m_reg - mn) * C); m_reg = mn; }
  float mnC = -mn * C;
#pragma unroll
  for (int r = 0; r < 16; ++r) p0[r] = fmaf(p0[r], C, mnC);
#pragma unroll
  for (int r = 0; r < 16; ++r) p1[r] = fmaf(p1[r], C, mnC);
#pragma unroll
  for (int r = 0; r < 16; ++r) p0[r] = __builtin_amdgcn_exp2f(p0[r]);
}
__device__ __forceinline__ void finishSM(f32x16& p0, f32x16& p1, float alpha, float& l_reg, bf16x8& pa0, bf16x8& pa1, bf16x8& pa2, bf16x8& pa3) {
#pragma unroll
  for (int r = 0; r < 16; ++r) p1[r] = __builtin_amdgcn_exp2f(p1[r]);
  float ps = 0;
#pragma unroll
  for (int r = 0; r < 16; ++r) ps += p0[r];
#pragma unroll
  for (int r = 0; r < 16; ++r) ps += p1[r];
  { auto rr = __builtin_amdgcn_permlane32_swap(__float_as_uint(ps), __float_as_uint(ps), false, false);
    ps = __uint_as_float(rr[0]) + __uint_as_float(rr[1]); }
  l_reg = l_reg * alpha + ps;
#define PKB(P, BASE, OUT) do { u32x4 w = {cvt_pk_bf16(P[BASE + 0], P[BASE + 1]), cvt_pk_bf16(P[BASE + 2], P[BASE + 3]), cvt_pk_bf16(P[BASE + 4], P[BASE + 5]), cvt_pk_bf16(P[BASE + 6], P[BASE + 7])}; \
    OUT = *reinterpret_cast<bf16x8*>(&w); } while (0)
  PKB(p0, 0, pa0); PKB(p0, 8, pa1); PKB(p1, 0, pa2); PKB(p1, 8, pa3);
#undef PKB
}
__device__ __forceinline__ void qkt(f32x16& p0, f32x16& p1, const char* Ks, const bf16x8* qr, int r32, int hi, int cmapB) {
  p0 = f32x16{}; p1 = f32x16{};
#pragma unroll
  for (int d0 = 0; d0 < 4; ++d0) { int cb = cmapB + (d0 * 16 + hi * 8) * 2;
    bf16x8 b0 = *reinterpret_cast<const bf16x8*>(Ks + KSWZ(r32, cb));
    bf16x8 b1 = *reinterpret_cast<const bf16x8*>(Ks + KSWZ(32 + r32, cb));
    p0 = __builtin_amdgcn_mfma_f32_32x32x16_bf16(b0, qr[d0], p0, 0, 0, 0);
    p1 = __builtin_amdgcn_mfma_f32_32x32x16_bf16(b1, qr[d0], p1, 0, 0, 0); }
}
__device__ __forceinline__ int v_st(int k, int c) { const int kk = k;     return ((kk >> 3) * 4 + (c >> 5)) * 512 + ((kk & 7) * 32 + (c & 31)) * 2; }
__device__ __forceinline__ int v_rd_base(int lane) { return ((lane & 3) << 3) | (((lane >> 2) & 3) << 6) | (((lane >> 4) & 1) << 5) | (((lane >> 5) & 1) << 8); }
constexpr int v_rd_off(int d0, int ks, int half) { return d0 * 512 + ks * 4096 + half * 2048; }
template <int OFF> __device__ __forceinline__ s16x4 tr_read(int vb) {
  s16x4 r; asm volatile("ds_read_b64_tr_b16 %0, %1 offset:%2" : "=&v"(r) : "v"(vb), "i"(OFF) : "memory"); return r;
}
template <int D0> __device__ __forceinline__ void pv_one(f32x16& od, int vb, bf16x8 pa0, bf16x8 pa1, bf16x8 pa2, bf16x8 pa3) {
  const s16x4 l0 = tr_read<v_rd_off(D0, 0, 0)>(vb), h0 = tr_read<v_rd_off(D0, 0, 1)>(vb), l1 = tr_read<v_rd_off(D0, 1, 0)>(vb), h1 = tr_read<v_rd_off(D0, 1, 1)>(vb);
  const s16x4 l2 = tr_read<v_rd_off(D0, 2, 0)>(vb), h2 = tr_read<v_rd_off(D0, 2, 1)>(vb), l3 = tr_read<v_rd_off(D0, 3, 0)>(vb), h3 = tr_read<v_rd_off(D0, 3, 1)>(vb);
  asm volatile("s_waitcnt lgkmcnt(0)" ::: "memory"); SBAR();
#define PK(L, H) (bf16x8){L[0], L[1], L[2], L[3], H[0], H[1], H[2], H[3]}
  od = __builtin_amdgcn_mfma_f32_32x32x16_bf16(PK(l0, h0), pa0, od, 0, 0, 0);
  od = __builtin_amdgcn_mfma_f32_32x32x16_bf16(PK(l1, h1), pa1, od, 0, 0, 0);
  od = __builtin_amdgcn_mfma_f32_32x32x16_bf16(PK(l2, h2), pa2, od, 0, 0, 0);
  od = __builtin_amdgcn_mfma_f32_32x32x16_bf16(PK(l3, h3), pa3, od, 0, 0, 0);
#undef PK
}
__device__ __forceinline__ void pv_d0(f32x16* o, int vb, bf16x8 pa0, bf16x8 pa1, bf16x8 pa2, bf16x8 pa3) {
  pv_one<0>(o[0], vb, pa0, pa1, pa2, pa3); pv_one<1>(o[1], vb, pa0, pa1, pa2, pa3); pv_one<2>(o[2], vb, pa0, pa1, pa2, pa3); pv_one<3>(o[3], vb, pa0, pa1, pa2, pa3);
}

__device__ __forceinline__ void attn_item(const bf16_t* __restrict__ proj, bf16_t* __restrict__ mix, int qrow0, int h, int crow0, int lrow0, int NT,
                                       float lam, float postscale, const float* __restrict__ gsub, char* lds) {
  const int tid = opaque_tid(), wid = tid >> 6, lane = tid & 63, r32 = lane & 31, hi = lane >> 5;
  const int cmap = wid >> 2, wq = wid & 3, cmapB = cmap * 128;
  char* V_lds = lds; char* K_lds = lds + 2 * SHM_V;
  float* wsx = (float*)(lds + WSCR_OFF) + wid * 64; float* li_l = wsx; float* al_l = wsx + 32;
  float m_reg = -1e30f, l_reg = 0; f32x16 o[4] = {}; bf16x8 qr[4];
  const bf16_t* Qw = proj + (size_t)(qrow0 + wq * 32 + r32) * INC + h * 128 + cmap * 64 + hi * 8;
#pragma unroll
  for (int d0 = 0; d0 < 4; ++d0) qr[d0] = *reinterpret_cast<const bf16x8*>(Qw + d0 * 16);
  const int sr = tid >> 4, sc = (tid & 15) * 8, vst0 = v_st(sr, sc), vst1 = v_st(32 + sr, sc);
  const int vb0 = (int)(uintptr_t)V_lds + v_rd_base(lane);
  const bf16_t* Kbase = proj + 512 + h * 128 + sc; const bf16_t* Vbase = proj + 1024 + h * 128 + sc;
  struct { bf16x8 vs0, vs1, ks0, ks1; } sr_[2];
#define KROW(k0) ((k0) < 256 ? crow0 + (k0) : lrow0 + (k0) - 256)
#define SLOAD(i, k0) do { const size_t _r0 = (size_t)(KROW(k0) + sr) * INC, _r1 = _r0 + (size_t)32 * INC; \
    sr_[i].vs0 = *reinterpret_cast<const bf16x8*>(Vbase + _r0); sr_[i].vs1 = *reinterpret_cast<const bf16x8*>(Vbase + _r1); \
    sr_[i].ks0 = *reinterpret_cast<const bf16x8*>(Kbase + _r0); sr_[i].ks1 = *reinterpret_cast<const bf16x8*>(Kbase + _r1); } while (0)
#define SWRITE(b, i) do { *(bf16x8*)(V_lds + (b) * SHM_V + vst0) = sr_[i].vs0;          \
    *(bf16x8*)(V_lds + (b) * SHM_V + vst1) = sr_[i].vs1; int kc = sc * 2;               \
    *(bf16x8*)(K_lds + (b) * SHM_K + KSWZ(sr, kc)) = sr_[i].ks0;                       \
    *(bf16x8*)(K_lds + (b) * SHM_K + KSWZ(32 + sr, kc)) = sr_[i].ks1; } while (0)
#define SWAIT() asm volatile("s_waitcnt vmcnt(4)" ::: "memory")
#define RESC(a) do { if (__any((a) < 1.f)) { \
    _Pragma("unroll") for (int d = 0; d < 4; ++d) _Pragma("unroll") for (int r = 0; r < 16; ++r) o[d][r] *= (a); } } while (0)
  f32x16 pA0, pA1, pB0, pB1; float mnA, mnB, alA, alB; bf16x8 pa0, pa1, pa2, pa3;
  constexpr int SE = 0, SO = 1;
  SLOAD(SE, 0); SLOAD(SO, KVBLK);
  SWRITE(0, SE); SLOAD(SE, 2 * KVBLK); __syncthreads();
  qkt(pA0, pA1, K_lds, qr, r32, hi, cmapB); partialSM(pA0, pA1, m_reg, mnA, alA);
  SWAIT(); SWRITE(1, SO); __syncthreads();
  for (int j = 1; j + 1 < NT; j += 2) {
    SBAR(); qkt(pB0, pB1, K_lds + SHM_K, qr, r32, hi, cmapB);
    finishSM(pA0, pA1, alA, l_reg, pa0, pa1, pa2, pa3); SBAR();
    SLOAD(SO, (j + 2) * KVBLK); SBAR();
    pv_d0(o, vb0, pa0, pa1, pa2, pa3); partialSM(pB0, pB1, m_reg, mnB, alB);
    __syncthreads(); SWAIT(); SWRITE(0, SE);
    RESC(alB); __syncthreads();
    SBAR(); qkt(pA0, pA1, K_lds, qr, r32, hi, cmapB);
    finishSM(pB0, pB1, alB, l_reg, pa0, pa1, pa2, pa3); SBAR();
    SLOAD(SE, (j + 3 < NT ? j + 3 : NT - 1) * KVBLK); SBAR();
    pv_d0(o, vb0 + SHM_V, pa0, pa1, pa2, pa3); partialSM(pA0, pA1, m_reg, mnA, alA);
    __syncthreads(); SWAIT(); SWRITE(1, SO);
    RESC(alA); __syncthreads();
  }
  SBAR(); qkt(pB0, pB1, K_lds + SHM_K, qr, r32, hi, cmapB);
  finishSM(pA0, pA1, alA, l_reg, pa0, pa1, pa2, pa3); SBAR();
  pv_d0(o, vb0, pa0, pa1, pa2, pa3); partialSM(pB0, pB1, m_reg, mnB, alB);
  __syncthreads(); RESC(alB);
  finishSM(pB0, pB1, alB, l_reg, pa0, pa1, pa2, pa3); SBAR();
  pv_d0(o, vb0 + SHM_V, pa0, pa1, pa2, pa3);
  const float rl = __builtin_amdgcn_rcpf(l_reg) * (cmap ? lam : 1.f);
  __syncthreads();
  float* OX = (float*)(lds + cmap * OX_BYTES) + (wq * 32 + r32) * OX_STRIDE + 4 * hi;
#pragma unroll
  for (int d0 = 0; d0 < 4; ++d0)
#pragma unroll
    for (int rg = 0; rg < 4; ++rg) { const f32x4 v = {o[d0][4 * rg + 0] * rl, o[d0][4 * rg + 1] * rl, o[d0][4 * rg + 2] * rl, o[d0][4 * rg + 3] * rl};
      *(f32x4*)(OX + d0 * 32 + 8 * rg) = v; }
  __syncthreads();
  { const int row = tid >> 2, q = tid & 3; const float* A = (const float*)lds + row * OX_STRIDE; const float* Bm = (const float*)(lds + OX_BYTES) + row * OX_STRIDE;
    f32x4 a[8]; float ss = 0.f;
#pragma unroll
    for (int i = 0; i < 8; ++i) { const int c4 = 4 * (q + 4 * i); a[i] = *(const f32x4*)(A + c4) - *(const f32x4*)(Bm + c4);
      ss += a[i][0] * a[i][0] + a[i][1] * a[i][1] + a[i][2] * a[i][2] + a[i][3] * a[i][3]; }
    ss += bperm_xor(ss, 1, lane); ss += bperm_xor(ss, 2, lane);
    const float rs = rsqrtf(ss * (1.f / 128.f) + EPS) * postscale;
    bf16_t* op = mix + (size_t)(qrow0 + row) * DM + h * 128;
#pragma unroll
    for (int i = 0; i < 8; ++i) { const int c4 = 4 * (q + 4 * i); const f32x4 g4 = *(const f32x4*)(gsub + c4); const f32x4 v = a[i] * g4 * rs;
      u32x2 w; w.x = cvt_pk_bf16(v[0], v[1]); w.y = cvt_pk_bf16(v[2], v[3]); *(u32x2*)(op + c4) = w; } }
  __syncthreads();
#undef KROW
#undef SLOAD
#undef SWRITE
#undef SWAIT
#undef RESC
}
}

__device__ __forceinline__ float bf2f(unsigned short b) { return __uint_as_float(((unsigned)b) << 16); }
__device__ __forceinline__ void unpack8(const bf16x8 v, float* f) {
#pragma unroll
  for (int j = 0; j < 8; ++j) f[j] = bf2f((unsigned short)v[j]);
}
__device__ __forceinline__ void mixer_item(const bf16_t* __restrict__ proj, bf16_t* __restrict__ mix, int rb, int p0, int Ls,
                                        const float* __restrict__ wconv, const bf16_t* __restrict__ wpoolT, const float* __restrict__ spool, char* lds) {
  const int tid = opaque_tid();
  constexpr int HS = 528;
  char* HT = lds;
  char* PT = lds + 80 * HS;
  bf16x8 hv[5];
#pragma unroll
  for (int k = 0; k < 5; ++k) { const int id = tid + k * NTHREADS; const int rr = id >> 5, ch = (id & 31) * 8; const int p = p0 - 8 + rr;
    hv[k] = (bf16x8){0, 0, 0, 0, 0, 0, 0, 0};
    if (id < 79 * 32 && p >= 0 && p < Ls) hv[k] = *reinterpret_cast<const bf16x8*>(proj + (size_t)(rb - 8 + rr) * INC + 2304 + ch); }
  bf16x8 rbg[4], ru0[4], rum[4], rup[4];
#pragma unroll
  for (int k = 0; k < 4; ++k) { const int id = tid + k * NTHREADS; const int tok = id >> 5, ch = (id & 31) * 8; const int p = p0 + tok;
    const bf16_t* rp = proj + (size_t)(rb + tok) * INC + 1536 + ch;
    const bf16_t* rm = (p > 0) ? rp - INC : rp; const bf16_t* rq = (p + 1 < Ls) ? rp + INC : rp;
    rbg[k] = *reinterpret_cast<const bf16x8*>(rp); ru0[k] = *reinterpret_cast<const bf16x8*>(rp + 256);
    rum[k] = *reinterpret_cast<const bf16x8*>(rm + 256); rup[k] = *reinterpret_cast<const bf16x8*>(rq + 256); }
#pragma unroll
  for (int k = 0; k < 5; ++k) { const int id = tid + k * NTHREADS; const int rr = id >> 5, ch = (id & 31) * 8;
    if (id < 79 * 32) *(bf16x8*)(HT + rr * HS + ch * 2) = hv[k]; }
#pragma unroll
  for (int k = 0; k < 4; ++k) { const int id = tid + k * NTHREADS; const int tok = id >> 5, ch = (id & 31) * 8; const int p = p0 + tok;
    float bg[8], um[8], u0[8], up[8], w0[8], w1[8], w2[8];
    unpack8(rbg[k], bg); unpack8(ru0[k], u0); unpack8(rum[k], um); unpack8(rup[k], up);
#pragma unroll
    for (int q = 0; q < 2; ++q) { const f32x4 a0 = *(const f32x4*)(wconv + ch + q * 4), a1 = *(const f32x4*)(wconv + 256 + ch + q * 4), a2 = *(const f32x4*)(wconv + 512 + ch + q * 4);
#pragma unroll
      for (int e = 0; e < 4; ++e) { w0[q * 4 + e] = a0[e]; w1[q * 4 + e] = a1[e]; w2[q * 4 + e] = a2[e]; } }
    const float fm = (p > 0) ? 1.f : 0.f, fp = (p + 1 < Ls) ? 1.f : 0.f;
    float y[8];
#pragma unroll
    for (int j = 0; j < 8; ++j) y[j] = bg[j] * (fm * um[j] * w0[j] + u0[j] * w1[j] + fp * up[j] * w2[j]);
    u32x4 w; w.x = cvt_pk_bf16(y[0], y[1]); w.y = cvt_pk_bf16(y[2], y[3]); w.z = cvt_pk_bf16(y[4], y[5]); w.w = cvt_pk_bf16(y[6], y[7]);
    *(u32x4*)(mix + (size_t)(rb + tok) * DM + 512 + ch) = w; }
  __syncthreads();
#pragma unroll
  for (int g = 0; g < 4; ++g) { const int hw = 1 << g; const int tok = tid >> 3, c0 = g * 64 + (tid & 7) * 8, colb = c0 * 2; const int p = p0 + tok;
    float sm[8] = {0.f, 0.f, 0.f, 0.f, 0.f, 0.f, 0.f, 0.f};
#pragma unroll
    for (int q = -hw; q < hw; ++q) { float f[8]; unpack8(*(const bf16x8*)(HT + (tok + 8 + q) * HS + colb), f);
#pragma unroll
      for (int j = 0; j < 8; ++j) sm[j] += f[j]; }
    int lo = p - hw, hi2 = p + hw - 1; if (lo < 0) lo = 0; if (hi2 > Ls - 1) hi2 = Ls - 1;
    float self[8]; unpack8(*(const bf16x8*)(HT + (tok + 8) * HS + colb), self);
    const float inv = 1.f / (float)(hi2 - lo + 1);
    const f32x4 s0 = *(const f32x4*)(spool + c0), s1 = *(const f32x4*)(spool + c0 + 4);
    float y[8];
#pragma unroll
    for (int j = 0; j < 4; ++j) { y[j] = (sm[j] * inv - self[j]) * s0[j]; y[4 + j] = (sm[4 + j] * inv - self[4 + j]) * s1[j]; }
    u32x4 w; w.x = cvt_pk_bf16(y[0], y[1]); w.y = cvt_pk_bf16(y[2], y[3]); w.z = cvt_pk_bf16(y[4], y[5]); w.w = cvt_pk_bf16(y[6], y[7]);
    *(u32x4*)(mix + (size_t)(rb + tok) * DM + 768 + c0) = w; }
  __syncthreads();
}

__device__ __forceinline__ float wave_sum(float v, int lane) {
#pragma unroll
  for (int o = 32; o >= 1; o >>= 1) v += bperm_xor(v, o, lane);
  return v;
}
__device__ __forceinline__ void unpack_bf8(const u32x4 w, float* f) {
  f[0] = __uint_as_float(w.x << 16); f[1] = __uint_as_float(w.x & 0xffff0000u); f[2] = __uint_as_float(w.y << 16); f[3] = __uint_as_float(w.y & 0xffff0000u);
  f[4] = __uint_as_float(w.z << 16); f[5] = __uint_as_float(w.z & 0xffff0000u); f[6] = __uint_as_float(w.w << 16); f[7] = __uint_as_float(w.w & 0xffff0000u);
}
__device__ __forceinline__ u32x4 pack_bf8(const float* f) { u32x4 w; w.x = cvt_pk_bf16(f[0], f[1]); w.y = cvt_pk_bf16(f[2], f[3]); w.z = cvt_pk_bf16(f[4], f[5]); w.w = cvt_pk_bf16(f[6], f[7]); return w; }
template <bool F32SRC>
__device__ __forceinline__ void norm_phase(const float* xlat, const float* xctx, bf16_t* xb, const float* g, const float* modl, int shi, int sci, bf16_t* act, int nrows) {
  constexpr int NRW = F32SRC ? 4 : 8;
  const int tid = opaque_tid(); const int lane = tid & 63; const int gw = blockIdx.x * 8 + (tid >> 6), nw = gridDim.x * 8;
  const int rpw = (nrows + nw - 1) / nw; const int r0 = gw * rpw; const int r1 = (r0 + rpw < nrows) ? r0 + rpw : nrows;
  float gg[16], scv[16], shv[16];
#pragma unroll
  for (int i = 0; i < 2; ++i)
#pragma unroll
    for (int q = 0; q < 2; ++q) { const f32x4 t = *(const f32x4*)(g + i * 512 + lane * 8 + q * 4); gg[i * 8 + q * 4 + 0] = t[0]; gg[i * 8 + q * 4 + 1] = t[1]; gg[i * 8 + q * 4 + 2] = t[2]; gg[i * 8 + q * 4 + 3] = t[3]; }
#pragma unroll
  for (int k = 0; k < 16; ++k) { scv[k] = 0.f; shv[k] = 0.f; }
  int bcur = -1;
#pragma unroll 1
  for (int rb = r0; rb < r1; rb += NRW) {
    u32x4 raw[NRW][2]; f32x4 rawf[F32SRC ? NRW : 1][4];
#pragma unroll
    for (int j = 0; j < NRW; ++j) { const int r = rb + j;
      if (F32SRC) {
#pragma unroll
        for (int i = 0; i < 4; ++i) rawf[F32SRC ? j : 0][i] = (f32x4){0.f, 0.f, 0.f, 0.f};
        if (r < r1) { const float* src = (r < MLAT) ? xlat + (size_t)r * DM : xctx + (size_t)(r - MLAT) * DM;
#pragma unroll
          for (int i = 0; i < 4; ++i) rawf[F32SRC ? j : 0][i] = *(const f32x4*)(src + (i >> 1) * 512 + lane * 8 + (i & 1) * 4); }
      } else {
        raw[j][0] = (u32x4){0u, 0u, 0u, 0u}; raw[j][1] = raw[j][0];
        if (r < r1) { raw[j][0] = *(const u32x4*)(xb + (size_t)r * DM + lane * 8); raw[j][1] = *(const u32x4*)(xb + (size_t)r * DM + 512 + lane * 8); } } }
#pragma unroll
    for (int j = 0; j < NRW; ++j) { const int r = rb + j; float v[16];
      if (F32SRC) {
#pragma unroll
        for (int i = 0; i < 4; ++i) { const f32x4 t = rawf[F32SRC ? j : 0][i]; v[i * 4 + 0] = t[0]; v[i * 4 + 1] = t[1]; v[i * 4 + 2] = t[2]; v[i * 4 + 3] = t[3]; }
      } else { unpack_bf8(raw[j][0], v); unpack_bf8(raw[j][1], v + 8); }
      float ss = 0.f;
#pragma unroll
      for (int k = 0; k < 16; ++k) ss += v[k] * v[k];
      const float rs = rsqrtf(wave_sum(ss, lane) * (1.f / DM) + EPS);
      if (r < r1) { const int b = (r < MLAT) ? (r >> 11) : 32;
        if (b != bcur) { bcur = b; const float* mb = modl + (size_t)b * (NMOD * DM);
#pragma unroll
          for (int i = 0; i < 2; ++i)
#pragma unroll
            for (int q = 0; q < 2; ++q) { const f32x4 t = *(const f32x4*)(mb + sci * DM + i * 512 + lane * 8 + q * 4), u = *(const f32x4*)(mb + shi * DM + i * 512 + lane * 8 + q * 4);
#pragma unroll
              for (int e = 0; e < 4; ++e) { scv[i * 8 + q * 4 + e] = t[e] + 1.f; shv[i * 8 + q * 4 + e] = u[e]; } } }
        if (F32SRC) { *(u32x4*)(xb + (size_t)r * DM + lane * 8) = pack_bf8(v); *(u32x4*)(xb + (size_t)r * DM + 512 + lane * 8) = pack_bf8(v + 8); }
        float y[16];
#pragma unroll
        for (int k = 0; k < 16; ++k) y[k] = (v[k] * rs) * gg[k] * scv[k] + shv[k];
        *(u32x4*)(act + (size_t)r * DM + lane * 8) = pack_bf8(y); *(u32x4*)(act + (size_t)r * DM + 512 + lane * 8) = pack_bf8(y + 8); } }
  }
}
__device__ __forceinline__ void final_norm(const bf16_t* xb, float* out, const float* g) {
  constexpr int NRW = 8;
  const int tid = opaque_tid(); const int lane = tid & 63; const int gw = blockIdx.x * 8 + (tid >> 6), nw = gridDim.x * 8;
  const int rpw = (MLAT + nw - 1) / nw; const int r0 = gw * rpw; const int r1 = (r0 + rpw < MLAT) ? r0 + rpw : MLAT;
  float gg[16];
#pragma unroll
  for (int i = 0; i < 2; ++i)
#pragma unroll
    for (int q = 0; q < 2; ++q) { const f32x4 t = *(const f32x4*)(g + i * 512 + lane * 8 + q * 4); gg[i * 8 + q * 4 + 0] = t[0]; gg[i * 8 + q * 4 + 1] = t[1]; gg[i * 8 + q * 4 + 2] = t[2]; gg[i * 8 + q * 4 + 3] = t[3]; }
#pragma unroll 1
  for (int rb = r0; rb < r1; rb += NRW) {
    u32x4 raw[NRW][2];
#pragma unroll
    for (int j = 0; j < NRW; ++j) { const int r = rb + j; raw[j][0] = (u32x4){0u, 0u, 0u, 0u}; raw[j][1] = raw[j][0];
      if (r < r1) { raw[j][0] = *(const u32x4*)(xb + (size_t)r * DM + lane * 8); raw[j][1] = *(const u32x4*)(xb + (size_t)r * DM + 512 + lane * 8); } }
#pragma unroll
    for (int j = 0; j < NRW; ++j) { const int r = rb + j; float v[16]; unpack_bf8(raw[j][0], v); unpack_bf8(raw[j][1], v + 8);
      float ss = 0.f;
#pragma unroll
      for (int k = 0; k < 16; ++k) ss += v[k] * v[k];
      const float rs = rsqrtf(wave_sum(ss, lane) * (1.f / DM) + EPS);
      if (r < r1) {
#pragma unroll
        for (int i = 0; i < 2; ++i)
#pragma unroll
          for (int q = 0; q < 2; ++q) { f32x4 o; o[0] = v[i * 8 + q * 4 + 0] * rs * gg[i * 8 + q * 4 + 0]; o[1] = v[i * 8 + q * 4 + 1] * rs * gg[i * 8 + q * 4 + 1];
            o[2] = v[i * 8 + q * 4 + 2] * rs * gg[i * 8 + q * 4 + 2]; o[3] = v[i * 8 + q * 4 + 3] * rs * gg[i * 8 + q * 4 + 3];
            *(f32x4*)(out + (size_t)r * DM + i * 512 + lane * 8 + q * 4) = o; } } }
  }
}
__device__ __forceinline__ void transpose_tile(const float* src, int ldS, bf16_t* dst, int ldD, int k0, int n0s, int n0d, float* tile) {
  const int tid = opaque_tid();
  { const int i = tid >> 3, j0 = (tid & 7) * 8; const float* p = src + (size_t)(k0 + i) * ldS + n0s + j0;
    const f32x4 a = *(const f32x4*)p, b = *(const f32x4*)(p + 4); float* t = tile + i * 65 + j0;
    t[0] = a[0]; t[1] = a[1]; t[2] = a[2]; t[3] = a[3]; t[4] = b[0]; t[5] = b[1]; t[6] = b[2]; t[7] = b[3]; }
  __syncthreads();
  { const int n = tid >> 3, kk0 = (tid & 7) * 8; float v[8];
#pragma unroll
    for (int j = 0; j < 8; ++j) v[j] = tile[(kk0 + j) * 65 + n];
    u32x4 w; w.x = cvt_pk_bf16(v[0], v[1]); w.y = cvt_pk_bf16(v[2], v[3]); w.z = cvt_pk_bf16(v[4], v[5]); w.w = cvt_pk_bf16(v[6], v[7]);
    *(u32x4*)(dst + (size_t)(n0d + n) * ldD + k0 + kk0) = w; }
  __syncthreads();
}
__device__ __forceinline__ void mod_item(const float* c, const float* cctx, const float* wada_l, const float* bada_l, float* mod_l, int n0, float* lds) {
  const int tid = opaque_tid();
  for (int i = tid; i < 33 * DM; i += NTHREADS) { const float v = (i < 32 * DM) ? c[i] : cctx[i - 32 * DM]; lds[i] = v / (1.f + __expf(-v)); }
  __syncthreads();
  const int col = tid & 127, kq = tid >> 7;
  float acc[33];
#pragma unroll
  for (int b = 0; b < 33; ++b) acc[b] = 0.f;
  const float* wp = wada_l + (size_t)(kq * 256) * (NMOD * DM) + n0 + col;
#pragma unroll 1
  for (int k = 0; k < 256; k += 8) {
    float w[8];
#pragma unroll
    for (int i = 0; i < 8; ++i) w[i] = wp[(size_t)(k + i) * (NMOD * DM)];
#pragma unroll
    for (int b = 0; b < 33; ++b) { const f32x4 s = *(const f32x4*)(lds + b * DM + kq * 256 + k), t = *(const f32x4*)(lds + b * DM + kq * 256 + k + 4);
      acc[b] += s[0] * w[0] + s[1] * w[1] + s[2] * w[2] + s[3] * w[3] + t[0] * w[4] + t[1] * w[5] + t[2] * w[6] + t[3] * w[7]; }
  }
  __syncthreads();
#pragma unroll
  for (int b = 0; b < 33; ++b) lds[(kq * 33 + b) * 128 + col] = acc[b];
  __syncthreads();
  for (int o = tid; o < 33 * 128; o += NTHREADS) { const int b = o >> 7, cc = o & 127;
    mod_l[(size_t)b * (NMOD * DM) + n0 + cc] = lds[(0 * 33 + b) * 128 + cc] + lds[(1 * 33 + b) * 128 + cc] + lds[(2 * 33 + b) * 128 + cc] + lds[(3 * 33 + b) * 128 + cc] + bada_l[n0 + cc]; }
  __syncthreads();
}

__device__ __forceinline__ void grid_bar(unsigned* ctr, unsigned target) {
  __syncthreads();
  if (threadIdx.x == 0) {
    __builtin_amdgcn_fence(__ATOMIC_RELEASE, "agent");
    asm volatile("s_waitcnt vmcnt(0)" ::: "memory");
    __hip_atomic_fetch_add(ctr, 1u, __ATOMIC_RELAXED, __HIP_MEMORY_SCOPE_AGENT);
    while (__hip_atomic_load(ctr, __ATOMIC_RELAXED, __HIP_MEMORY_SCOPE_AGENT) < target) __builtin_amdgcn_s_sleep(2);
    __builtin_amdgcn_fence(__ATOMIC_ACQUIRE, "agent");
    asm volatile("s_waitcnt vmcnt(0)" ::: "memory");
  }
  __syncthreads();
}
__global__ void __launch_bounds__(NTHREADS, 2) fwd_megakernel(Params P) {
  extern __shared__ __attribute__((aligned(16))) unsigned char lds[];
  cg::grid_group grid = cg::this_grid();
  const int tid = threadIdx.x, G = gridDim.x, bid = blockIdx.x;
  unsigned char* ws = P.ws;
  bf16_t* H2 = (bf16_t*)(ws + WS_H2); float* XCH = (float*)(ws + WS_XCH); unsigned* CNT = (unsigned*)(ws + WS_CNT);
  bf16_t* XB = (bf16_t*)(ws + WS_XB); bf16_t* ACT = (bf16_t*)(ws + WS_ACT); bf16_t* PROJ = (bf16_t*)(ws + WS_PROJ);
  bf16_t* WB = (bf16_t*)(ws + WS_W); bf16_t* WPOOL = (bf16_t*)(ws + WS_WPOOL); float* MOD = (float*)(ws + WS_MOD);
  float* ROPE = (float*)(ws + WS_ROPE); float* LAMV = (float*)(ws + WS_LAM);
  const float* x_in = P.in[0]; const float* ctx_in = P.in[2];

  for (int rep = 0; rep < ((DUP & 8) ? 2 : 1); ++rep)
  if constexpr (EN(0)) {
    constexpr int TILES_L = 640 + 256 + 1408 + 704 + 4;
    const int nItems = 192 + DEPTH * TILES_L + 1;
    for (int it = bid; it < nItems; it += G) {
      if (it < 192) { const int l = it / 48, nb = it % 48;
        mod_item(P.in[1], P.in[3], P.in[4] + (size_t)l * DM * NMOD * DM, P.in[5] + (size_t)l * NMOD * DM, MOD + (size_t)l * 33 * NMOD * DM, nb * 128, (float*)lds);
      } else if (it < 192 + DEPTH * TILES_L) {
        const int t = it - 192; const int l = t / TILES_L; int r = t % TILES_L; bf16_t* wl = WB + (size_t)l * W_LAYER_E; float* tile = (float*)lds;
        if (r < 640 && (r % 40) >= 36) {
          const int g = (r % 40) - 36, k0 = (r / 40) * 64; const int i = tid >> 3, j0 = (tid & 7) * 8; float* At = tile; float* Wt = tile + 64 * 65;
          { const float* pa = P.in[7] + (size_t)l * DM * INC + (size_t)(k0 + i) * INC + 2304 + g * 64 + j0; const float* pw = P.in[14] + (size_t)(l * 4 + g) * 4096 + i * 64 + j0;
            const f32x4 a0 = *(const f32x4*)pa, a1 = *(const f32x4*)(pa + 4), w0 = *(const f32x4*)pw, w1 = *(const f32x4*)(pw + 4);
#pragma unroll
            for (int e = 0; e < 4; ++e) { At[i * 65 + j0 + e] = a0[e]; At[i * 65 + j0 + 4 + e] = a1[e]; Wt[i * 64 + j0 + e] = w0[e]; Wt[i * 64 + j0 + 4 + e] = w1[e]; } }
          __syncthreads();
          float o[8] = {0.f, 0.f, 0.f, 0.f, 0.f, 0.f, 0.f, 0.f};
          for (int c = 0; c < 64; ++c) { const float a = At[i * 65 + c]; const f32x4 w0 = *(const f32x4*)(Wt + c * 64 + j0), w1 = *(const f32x4*)(Wt + c * 64 + j0 + 4);
#pragma unroll
            for (int e = 0; e < 4; ++e) { o[e] += a * w0[e]; o[4 + e] += a * w1[e]; } }
          __syncthreads();
#pragma unroll
          for (int e = 0; e < 8; ++e) At[i * 65 + j0 + e] = o[e];
          __syncthreads();
          { const int n = tid >> 3, kk0 = (tid & 7) * 8; float v[8];
#pragma unroll
            for (int j = 0; j < 8; ++j) v[j] = At[(kk0 + j) * 65 + n];
            u32x4 w; w.x = cvt_pk_bf16(v[0], v[1]); w.y = cvt_pk_bf16(v[2], v[3]); w.z = cvt_pk_bf16(v[4], v[5]); w.w = cvt_pk_bf16(v[6], v[7]);
            *(u32x4*)(wl + (size_t)(2304 + g * 64 + n) * DM + k0 + kk0) = w; }
          __syncthreads();
        } else if (r < 640) { const int n0 = (r % 40) * 64; int nd = n0;
          if (n0 >= 1792 && n0 < 2304) { const int xin = n0 >= 2048; const int c = n0 - (xin ? 2048 : 1792); nd = 1792 + (c / 128) * 256 + (xin ? 128 : 0) + (c % 128); }
          transpose_tile(P.in[7] + (size_t)l * DM * INC, INC, wl, DM, (r / 40) * 64, n0, nd, tile); }
        else if ((r -= 640) < 256) { transpose_tile(P.in[16] + (size_t)l * DM * DM, DM, wl + W_IN_E, DM, (r / 16) * 64, (r % 16) * 64, (r % 16) * 64, tile); }
        else if ((r -= 256) < 1408) { const int n0 = (r % 88) * 64; const int up = n0 >= FFN; const int j0 = up ? n0 - FFN : n0; const int nd = 256 * (j0 / 128) + (up ? 128 : 0) + (j0 % 128);
          transpose_tile(P.in[18] + (size_t)l * DM * 2 * FFN, 2 * FFN, wl + W_IN_E + W_OUT_E, DM, (r / 88) * 64, n0, nd, tile); }
        else if ((r -= 1408) < 704) { transpose_tile(P.in[19] + (size_t)l * FFN * DM, DM, wl + W_IN_E + W_OUT_E + W_GU_E, FFN, (r / 16) * 64, (r % 16) * 64, (r % 16) * 64, tile); }
        else { r -= 704; transpose_tile(P.in[14] + (size_t)(l * 4 + r) * 4096, 64, WPOOL + (size_t)(l * 4 + r) * 4096, 64, 0, 0, 0, tile); }
      } else {
        for (int i = tid; i < 64 * 16; i += NTHREADS) { const int pos = i >> 4, f = i & 15; const float inv = 1.0f / powf(10000.0f, (float)f / 16.0f); const float ang = (float)pos * inv;
          ROPE[i] = cosf(ang); ROPE[1024 + i] = sinf(ang); }
        if (tid < DEPTH) { const int l = tid; float d1 = 0.f, d2 = 0.f;
          for (int i = 0; i < 64; ++i) { d1 += P.in[8][l * 64 + i] * P.in[9][l * 64 + i]; d2 += P.in[10][l * 64 + i] * P.in[11][l * 64 + i]; }
          const float li = 0.8f - 0.6f * expf(-0.3f * (float)l);
          LAMV[l * 2] = expf(d1) - expf(d2) + li; LAMV[l * 2 + 1] = 1.f - li; }
      }
    }
  }
  for (int i = bid * NTHREADS + tid; i < NFUSE * MALL; i += G * NTHREADS) { const f32x4 m1 = {-1.f, -1.f, -1.f, -1.f}; f32x4* sp = (f32x4*)XCH + i;
    asm volatile("global_store_dwordx4 %0, %1, off sc1" :: "v"(sp), "v"(m1) : "memory"); }
  for (int i = bid * NTHREADS + tid; i < 2 * DM; i += G * NTHREADS) ((float*)CNT)[i] = 0.f;
  const bool fuse_ok = (G == 256);
  unsigned* BARC = (unsigned*)(ws + WS_BAR); unsigned nbar = 0;
  if (bid == 0 && tid == 0) __hip_atomic_store(BARC, 0u, __ATOMIC_RELAXED, __HIP_MEMORY_SCOPE_AGENT);
  grid.sync();

  for (int l = 0; l < DEPTH; ++l) {
    const bool last = (l == DEPTH - 1);
    const float* modl = MOD + (size_t)l * 33 * NMOD * DM;
    const bf16_t* wl = WB + (size_t)l * W_LAYER_E;
    if (l == 0) { norm_phase<true>(x_in, ctx_in, XB, P.in[6] + l * DM, modl, 0, 1, ACT, MALL); grid_bar(BARC, (unsigned)G * (++nbar)); }
    else if (!fuse_ok) { norm_phase<false>(nullptr, nullptr, XB, P.in[6] + l * DM, modl, 0, 1, ACT, MALL); grid_bar(BARC, (unsigned)G * (++nbar)); }
    for (int rep = 0; rep < ((DUP & 2) ? 2 : 1); ++rep)
    if constexpr (EN(2)) { pg8::Gemm g{ACT, wl, DM}; pg8::Sched S; S.init(INC / 256, MCTX / 256, last ? 2 : 0, last ? 4 : INC / 256, G, bid);
      pg8::EpiProj E{PROJ, ROPE, ROPE + 1024};
      pg8::gemm_phase<pg8::EpiProj>((LAS unsigned char*)lds, g, S, E); }
    grid_bar(BARC, (unsigned)G * (++nbar));
    for (int rep = 0; rep < ((DUP & 1) ? 2 : 1); ++rep)
    if constexpr (EN(3)) { const float lam = LAMV[l * 2], post = LAMV[l * 2 + 1]; const float* gsub = P.in[12] + l * 128;
      const int nAttL = NB * 4 * 16, nAttC = last ? 0 : NB * 4 * 2, nMix = last ? MLAT / 64 : MALL / 64;
      const int nItems = nAttL + nAttC + nMix;
      for (int it = bid; it < nItems; it += G) {
        if (it < nAttL + nAttC) { int bh, qb, qrow0, lrow0, NT;
          if (it < nAttL) {
            if (G == 256) { const int j = it & 255, k = it >> 8, xcd = j & 7, slot = j >> 3; bh = k * 16 + xcd * 2 + (slot >> 4); qb = slot & 15; } else { bh = it >> 4; qb = it & 15; }
            qrow0 = (bh >> 2) * SEQ + qb * 128; lrow0 = (bh >> 2) * SEQ; NT = 36;
          } else { const int id = it - nAttL; bh = id >> 1; qb = id & 1; qrow0 = MLAT + (bh >> 2) * CTXL + qb * 128; lrow0 = 0; NT = 4; }
          att::attn_item(PROJ, ACT, qrow0, bh & 3, MLAT + (bh >> 2) * CTXL, lrow0, NT, lam, post, gsub, (char*)lds);
        } else { const int tile = it - nAttL - nAttC; int rb, p0, Ls;
          if (tile < MLAT / 64) { rb = tile * 64; p0 = (tile & 31) * 64; Ls = SEQ; } else { rb = tile * 64; p0 = (tile & 3) * 64; Ls = CTXL; }
          for (int rep2 = 0; rep2 < ((DUP & 32) ? 2 : 1); ++rep2)
          mixer_item(PROJ, ACT, rb, p0, Ls, P.in[13] + l * 768, WPOOL + (size_t)l * 4 * 4096, P.in[15] + l * 256, (char*)lds);
        }
      }
    }
    grid_bar(BARC, (unsigned)G * (++nbar));
    if constexpr (EN(4)) { pg8::Gemm g{ACT, wl + W_IN_E, DM}; pg8::Sched S; S.init(DM / 256, last ? 0 : MCTX / 256, 0, DM / 256, G, bid);
      pg8::EpiResNorm E{XB, modl + 2 * DM, fuse_ok, H2, P.in[17] + l * DM, modl, 3, 4, XCH + (size_t)(2 * l) * MALL * 4, (LAS unsigned char*)lds + pg8::STAGE_BYTES, nullptr, NMOD * DM};
      pg8::gemm_phase<pg8::EpiResNorm>((LAS unsigned char*)lds, g, S, E); }
    grid_bar(BARC, (unsigned)G * (++nbar));
    if (!fuse_ok) { norm_phase<false>(nullptr, nullptr, XB, P.in[17] + l * DM, modl, 3, 4, H2, last ? MLAT : MALL); grid_bar(BARC, (unsigned)G * (++nbar)); }
    for (int rep = 0; rep < ((DUP & 2) ? 2 : 1); ++rep)
    if constexpr (EN(6)) { pg8::Gemm g{H2, wl + W_IN_E + W_OUT_E, DM}; pg8::Sched S; S.init(2 * FFN / 256, last ? 0 : MCTX / 256, 0, 2 * FFN / 256, G, bid);
      pg8::EpiSwi E{PROJ};
      pg8::gemm_phase<pg8::EpiSwi>((LAS unsigned char*)lds, g, S, E); }
    grid_bar(BARC, (unsigned)G * (++nbar));
    if constexpr (EN(7)) { pg8::Gemm g{PROJ, wl + W_IN_E + W_OUT_E + W_GU_E, FFN}; pg8::Sched S; S.init(DM / 256, last ? 0 : MCTX / 256, 0, DM / 256, G, bid);
      const int ln = last ? l : l + 1;
      const bool fin = last && fuse_ok;
      pg8::EpiResNorm E{XB, modl + 5 * DM, fuse_ok, ACT, fin ? P.in[20] : P.in[6] + ln * DM, fin ? (const float*)CNT : MOD + (size_t)ln * 33 * NMOD * DM, 0, 1, XCH + (size_t)(2 * l + 1) * MALL * 4, (LAS unsigned char*)lds + pg8::STAGE_BYTES, fin ? P.out : nullptr, fin ? 0 : NMOD * DM};
      pg8::gemm_phase<pg8::EpiResNorm>((LAS unsigned char*)lds, g, S, E); }
    grid_bar(BARC, (unsigned)G * (++nbar));
  }
  if (!fuse_ok) final_norm(XB, P.out, P.in[20]);
}

extern "C" void kernel_launch(void* const* d_in, const int* in_sizes, int n_in, void* d_out, int out_size, void* d_ws, size_t ws_size, hipStream_t stream) {
  static int grid_blocks = 0;
  if (grid_blocks == 0) {
    if (n_in != 21 || out_size != MLAT * DM || ws_size < WS_END) { fprintf(stderr, "kernel_launch: unexpected shapes n_in %d out %d ws %zu (need %zu)\n", n_in, out_size, ws_size, (size_t)WS_END); grid_blocks = -1; return; }
    int dev = 0, cus = 0, per_cu = 0;
    hipGetDevice(&dev); hipDeviceGetAttribute(&cus, hipDeviceAttributeMultiprocessorCount, dev);
    if (hipFuncSetAttribute((const void*)fwd_megakernel, hipFuncAttributeMaxDynamicSharedMemorySize, LDS_BYTES) != hipSuccess) { fprintf(stderr, "kernel_launch: hipFuncSetAttribute failed\n"); grid_blocks = -1; return; }
    hipOccupancyMaxActiveBlocksPerMultiprocessor(&per_cu, (const void*)fwd_megakernel, NTHREADS, LDS_BYTES);
    if (per_cu < 1) { fprintf(stderr, "kernel_launch: occupancy query says %d blocks per CU\n", per_cu); per_cu = 1; }
    grid_blocks = cus * 1;
    (void)hipGetLastError();
  }
  if (grid_blocks < 0) return;
  Params p{};
  for (int i = 0; i < 21; ++i) p.in[i] = (const float*)d_in[i];
  p.out = (float*)d_out; p.ws = (unsigned char*)d_ws;
  void* args[] = {&p};
  hipError_t e = hipLaunchCooperativeKernel((const void*)fwd_megakernel, dim3(grid_blocks), dim3(NTHREADS), args, LDS_BYTES, stream);
  if (e != hipSuccess) fprintf(stderr, "cooperative launch failed: %s (grid %d)\n", hipGetErrorString(e), grid_blocks);
}
```

```cpp
#include <hip/hip_runtime.h>
#include <hip/hip_cooperative_groups.h>
#include <cstdio>
#include <cstdint>
namespace cg = cooperative_groups;

#define LAS __attribute__((address_space(3)))
typedef unsigned short bf16_t;
typedef short bf16x8 __attribute__((ext_vector_type(8)));
typedef short s16x4 __attribute__((ext_vector_type(4)));
typedef float f32x4 __attribute__((ext_vector_type(4)));
typedef float f32x16 __attribute__((ext_vector_type(16)));
typedef unsigned u32x4 __attribute__((ext_vector_type(4)));
typedef unsigned u32x2 __attribute__((ext_vector_type(2)));

constexpr int DM = 1024, NB = 32, SEQ = 2048, DEPTH = 4, CTXL = 256;
constexpr int MLAT = NB * SEQ, MCTX = NB * CTXL, MALL = MLAT + MCTX;
constexpr int INC = 2560, FFN = 2816, NMOD = 6;
constexpr float EPS = 1e-6f;
constexpr int NTHREADS = 512;
constexpr int LDS_BYTES = 152 * 1024;

constexpr size_t WS_XB   = 0;
constexpr size_t WS_ACT  = WS_XB + (size_t)MALL * DM * 2;
constexpr size_t WS_PROJ = WS_ACT + (size_t)MALL * DM * 2;
constexpr size_t WS_W    = WS_PROJ + (size_t)MALL * FFN * 2;
constexpr size_t W_IN_E = (size_t)INC * DM, W_OUT_E = (size_t)DM * DM, W_GU_E = (size_t)2 * FFN * DM, W_DN_E = (size_t)DM * FFN;
constexpr size_t W_LAYER_E = W_IN_E + W_OUT_E + W_GU_E + W_DN_E;
constexpr size_t WS_WPOOL = WS_W + W_LAYER_E * 2 * DEPTH;
constexpr size_t WS_MOD  = WS_WPOOL + (size_t)DEPTH * 4 * 64 * 64 * 2;
constexpr size_t WS_ROPE = WS_MOD + (size_t)DEPTH * 33 * NMOD * DM * 4;
constexpr size_t WS_LAM  = WS_ROPE + 2 * 64 * 16 * 4;
constexpr size_t WS_BAR  = WS_LAM + 256;
constexpr size_t WS_H2   = WS_BAR + 256;
constexpr int    NFUSE   = 2 * DEPTH;
constexpr size_t WS_XCH  = WS_H2 + (size_t)MALL * DM * 2;
constexpr size_t WS_CNT  = WS_XCH + (size_t)NFUSE * MALL * 4 * 4;
constexpr size_t WS_END  = WS_CNT + (size_t)NFUSE * (MALL / 256) * 256;

#ifndef ONLY
#define ONLY -1
#endif
#define EN(n) (ONLY < 0 || ONLY == (n))
#ifndef DUP
#define DUP 0
#endif
struct Params { const float* in[21]; float* out; unsigned char* ws; };

__device__ __forceinline__ int opaque_tid() { int t = threadIdx.x; asm volatile("" : "+v"(t)); return t; }
__device__ __forceinline__ float bperm_xor(float v, int m, int lane) { return __builtin_bit_cast(float, __builtin_amdgcn_ds_bpermute((lane ^ m) << 2, __builtin_bit_cast(int, v))); }
__device__ __forceinline__ unsigned cvt_pk_bf16(float lo, float hi) { unsigned r; asm volatile("v_cvt_pk_bf16_f32 %0, %1, %2" : "=v"(r) : "v"(lo), "v"(hi)); return r; }

namespace pg8 {
constexpr int BM = 256, BK = 64, HALF = 128, HTB = HALF * BK * 2, STAGE_BYTES = 8 * HTB;
__device__ __forceinline__ int lds_byte(int r, int c) { const int st = (r >> 4) * 2 + (c >> 5), rr = r & 15, cc = c & 31, ob = rr * 64 + cc * 2; return st * 1024 + (ob ^ (((ob >> 9) & 1) << 5)); }
__device__ __forceinline__ void stage_rc(int b, int& R, int& C) { const int st = b / 1024, sb = b % 1024, swz = sb ^ (((sb >> 9) & 1) << 5); R = (st >> 1) * 16 + swz / 64; C = (st & 1) * 32 + (swz % 64) / 2; }
__device__ __forceinline__ int perm32(int rho) { const int n = rho >> 4, i = rho & 15; return 8 * (i >> 2) + 4 * n + (i & 3); }
struct Unit { int pm, pn; };
struct Gemm { const bf16_t* A; const bf16_t* Bt; int K; };

struct Sched {
    int nN, nLat, nTot, G, c, cpn0, cnN;
    __device__ void init(int nN_, int nCtxRows, int cpn0_, int cnN_, int G_, int c_) { nN = nN_; nLat = 256 * nN_; cpn0 = cpn0_; cnN = cnN_; nTot = nLat + nCtxRows * cnN_; G = G_; c = c_; }
    __device__ __forceinline__ bool next(int i, Unit& u) const {
        const int L = i * G + c; if (L >= nTot) return false;
        if (L < nLat) {
            const int q = nLat >> 3; const int wgid = (L & 7) * q + (L >> 3);
            const int nig = 8 * nN, gid = wgid / nig, rem = wgid % nig;
            u.pm = gid * 8 + (rem & 7); u.pn = rem >> 3;
        } else { const int Lc = L - nLat; u.pm = 256 + Lc / cnN; u.pn = cpn0 + Lc % cnN; }
        return true;
    }
};

template <class Epi>
__device__ __forceinline__ void gemm_phase(LAS unsigned char* lds, const Gemm g, const Sched& S, const Epi& E) {
    const int tid = opaque_tid(), wid = __builtin_amdgcn_readfirstlane(tid >> 6), lane = tid & 63, wr = wid >> 2, wc = wid & 3, fr = lane & 15, fq = lane >> 4;
    const int K = g.K, nt = K / BK;
    unsigned voffA[2], voffB[2];
#pragma unroll
    for (int i = 0; i < 2; ++i) { int R, C; stage_rc(tid * 16 + i * 8192, R, C); const int Rb = Epi::PERM ? ((R & ~31) + perm32(R & 31)) : R;
        voffA[i] = (unsigned)(R * K + C) * 2u; voffB[i] = (unsigned)(Rb * K + C) * 2u; }
    const size_t kstep = (size_t)(BK * 2);
    const size_t hstep = (size_t)HALF * K * 2;
    const size_t tstep = 2 * hstep;
    const unsigned ldsw = (unsigned)wid * 1024u;
    const int aoff = lds_byte(wr * 64 + fr, fq * 8), boff = lds_byte(wc * 32 + fr, fq * 8);
#define PG8_SA(b, h) (((b) * 2 + (h)) * HTB)
#define PG8_SB(b, h) ((4 + (b) * 2 + (h)) * HTB)
#define PG8_STAGE(bufoff, gbase, voff) do { _Pragma("unroll") for (int _i = 0; _i < 2; ++_i) \
        __builtin_amdgcn_global_load_lds((const unsigned*)((const char*)(gbase) + (voff)[_i]), (LAS unsigned*)(lds + (bufoff) + ldsw + _i * 8192), 16, 0, 0); } while (0)
#define PG8_LDA(dst, b, h) do { _Pragma("unroll") for (int m = 0; m < 4; ++m) _Pragma("unroll") for (int k = 0; k < 2; ++k) dst[m][k] = *(const LAS bf16x8*)(lds + PG8_SA(b, h) + aoff + m * 2048 + k * 1024); } while (0)
#define PG8_LDB(dst, b, h) do { _Pragma("unroll") for (int n = 0; n < 2; ++n) _Pragma("unroll") for (int k = 0; k < 2; ++k) dst[n][k] = *(const LAS bf16x8*)(lds + PG8_SB(b, h) + boff + n * 2048 + k * 1024); } while (0)
#define PG8_MMA(ai, bj, At, Bt) do { __builtin_amdgcn_s_setprio(1); _Pragma("unroll") for (int m = 0; m < 4; ++m) _Pragma("unroll") for (int n = 0; n < 2; ++n) _Pragma("unroll") for (int k = 0; k < 2; ++k) \
        acc[ai][bj][m][n] = __builtin_amdgcn_mfma_f32_16x16x32_bf16(Bt[n][k], At[m][k], acc[ai][bj][m][n], 0, 0, 0); __builtin_amdgcn_s_setprio(0); } while (0)
#define PG8_WAIT_V(n) asm volatile("s_waitcnt vmcnt(" #n ")" ::: "memory")
#define PG8_WAIT_L(n) asm volatile("s_waitcnt lgkmcnt(" #n ")" ::: "memory")
#define PG8_BAR __builtin_amdgcn_s_barrier()
#define PG8_SCHED __builtin_amdgcn_sched_barrier(0)
    Unit cur, nxt; int ui = 0;
    if (!S.next(0, cur)) return;
    f32x4 acc[2][2][4][2];
#pragma unroll
    for (int a = 0; a < 2; ++a)
#pragma unroll
        for (int b = 0; b < 2; ++b)
#pragma unroll
            for (int m = 0; m < 4; ++m)
#pragma unroll
                for (int n = 0; n < 2; ++n) acc[a][b][m][n] = (f32x4){0.f, 0.f, 0.f, 0.f};
    bf16x8 At[4][2], B0[2][2], B1[2][2];
    const char* cA = (const char*)g.A + (size_t)cur.pm * tstep; const char* cB = (const char*)g.Bt + (size_t)cur.pn * tstep;
    PG8_STAGE(PG8_SB(0, 0), cB, voffB); PG8_STAGE(PG8_SB(0, 1), cB + hstep, voffB); PG8_STAGE(PG8_SA(0, 0), cA, voffA); PG8_STAGE(PG8_SA(0, 1), cA + hstep, voffA);
    if (wr == 1) PG8_BAR;
    PG8_WAIT_V(2); PG8_BAR;
    PG8_STAGE(PG8_SB(1, 0), cB + kstep, voffB); PG8_STAGE(PG8_SA(1, 0), cA + kstep, voffA); PG8_STAGE(PG8_SB(1, 1), cB + hstep + kstep, voffB);
    PG8_WAIT_V(6); PG8_BAR;
    for (;;) {
        const bool has_next = S.next(ui + 1, nxt);
        const char* nA = has_next ? (const char*)g.A + (size_t)nxt.pm * tstep : cA; const char* nB = has_next ? (const char*)g.Bt + (size_t)nxt.pn * tstep : cB;
        for (int t = 0; t < nt; t += 2) {
            const bool last = (t == nt - 2);
            const char* a1 = cA + (size_t)(t + 1) * kstep;
            const char* a2 = last ? nA : cA + (size_t)(t + 2) * kstep; const char* b2 = last ? nB : cB + (size_t)(t + 2) * kstep;
            const char* a3 = a2 + kstep; const char* b3 = b2 + kstep;
            PG8_LDB(B0, 0, 0); PG8_LDB(B1, 0, 1); PG8_SCHED; PG8_LDA(At, 0, 0); PG8_STAGE(PG8_SA(1, 1), a1 + hstep, voffA);
            PG8_WAIT_V(8); PG8_WAIT_L(0); PG8_BAR; PG8_MMA(0, 0, At, B0); PG8_MMA(0, 1, At, B1); PG8_BAR; PG8_SCHED;
            PG8_LDA(At, 0, 1); PG8_STAGE(PG8_SB(0, 0), b2, voffB); PG8_STAGE(PG8_SB(0, 1), b2 + hstep, voffB); PG8_STAGE(PG8_SA(0, 0), a2, voffA);
            PG8_WAIT_V(8); PG8_WAIT_L(0); PG8_BAR; PG8_MMA(1, 0, At, B0); PG8_MMA(1, 1, At, B1); PG8_BAR; PG8_SCHED;
            PG8_LDB(B0, 1, 0); PG8_LDB(B1, 1, 1); PG8_SCHED; PG8_LDA(At, 1, 0); PG8_STAGE(PG8_SA(0, 1), a2 + hstep, voffA);
            PG8_WAIT_V(8); PG8_WAIT_L(0); PG8_BAR; PG8_MMA(0, 0, At, B0); PG8_MMA(0, 1, At, B1); PG8_BAR; PG8_SCHED;
            PG8_LDA(At, 1, 1); PG8_STAGE(PG8_SB(1, 0), b3, voffB); PG8_STAGE(PG8_SB(1, 1), b3 + hstep, voffB); PG8_STAGE(PG8_SA(1, 0), a3, voffA);
            PG8_WAIT_V(8); PG8_WAIT_L(0); PG8_BAR; PG8_MMA(1, 0, At, B0); PG8_MMA(1, 1, At, B1); PG8_BAR; PG8_SCHED;
        }
        if (wr == 0) PG8_BAR;
        E(acc, cur, wr, wc, fr, fq);
        if (!has_next) break;
#pragma unroll
        for (int a = 0; a < 2; ++a)
#pragma unroll
            for (int b = 0; b < 2; ++b)
#pragma unroll
                for (int m = 0; m < 4; ++m)
#pragma unroll
                    for (int n = 0; n < 2; ++n) acc[a][b][m][n] = (f32x4){0.f, 0.f, 0.f, 0.f};
        cur = nxt; cA = nA; cB = nB; ++ui;
        if (wr == 1) PG8_BAR;
    }
    PG8_WAIT_V(0);
    PG8_BAR;
#undef PG8_SA
#undef PG8_SB
#undef PG8_STAGE
#undef PG8_LDA
#undef PG8_LDB
#undef PG8_MMA
#undef PG8_WAIT_V
#undef PG8_WAIT_L
#undef PG8_BAR
#undef PG8_SCHED
}

struct EpiProj {
    static constexpr bool PERM = true;
    bf16_t* O; const float* cosT; const float* sinT;
    __device__ __forceinline__ void operator()(const f32x4 (&acc)[2][2][4][2], const Unit& u, int wr, int wc, int fr, int fq) const {
        const int row0 = u.pm * BM + wr * 64 + fr, col0 = u.pn * BM + wc * 32 + 8 * fq;
        const bool rope = (u.pm < 256) && (u.pn < 4);
        const float sgn = (fq & 2) ? 1.f : -1.f; const int lane_ = (fq << 4) | fr;
#pragma unroll
        for (int ai = 0; ai < 2; ++ai)
#pragma unroll
            for (int m = 0; m < 4; ++m) {
                const int r = row0 + ai * HALF + m * 16;
                f32x4 c0 = {1.f, 1.f, 1.f, 1.f}, c1 = c0, s0 = {0.f, 0.f, 0.f, 0.f}, s1 = s0;
                if (rope) { const int p = r & (SEQ - 1); const int pos = (wc & 1) ? (p & 63) : (p >> 6); const int f0 = 8 * (fq & 1);
                    c0 = *(const f32x4*)(cosT + pos * 16 + f0); c1 = *(const f32x4*)(cosT + pos * 16 + f0 + 4);
                    s0 = *(const f32x4*)(sinT + pos * 16 + f0); s1 = *(const f32x4*)(sinT + pos * 16 + f0 + 4); }
                if (u.pn == 7 || u.pn == 8) {
                    const f32x4 u0 = acc[ai][0][m][0] * acc[ai][1][m][0], u1 = acc[ai][0][m][1] * acc[ai][1][m][1];
                    u32x4 w; w.x = cvt_pk_bf16(u0[0], u0[1]); w.y = cvt_pk_bf16(u0[2], u0[3]); w.z = cvt_pk_bf16(u1[0], u1[1]); w.w = cvt_pk_bf16(u1[2], u1[3]);
                    *(u32x4*)(O + (size_t)r * INC + 1792 + (u.pn - 7) * HALF + wc * 32 + 8 * fq) = w; continue; }
                bf16_t* rowp = O + (size_t)r * INC + col0;
#pragma unroll
                for (int bj = 0; bj < 2; ++bj) { f32x4 v0 = acc[ai][bj][m][0], v1 = acc[ai][bj][m][1];
                    if (rope) {
#pragma unroll
                        for (int j = 0; j < 4; ++j) { const float p0 = bperm_xor(v0[j], 32, lane_), p1 = bperm_xor(v1[j], 32, lane_);
                            v0[j] = v0[j] * c0[j] + sgn * p0 * s0[j]; v1[j] = v1[j] * c1[j] + sgn * p1 * s1[j]; } }
                    u32x4 w; w.x = cvt_pk_bf16(v0[0], v0[1]); w.y = cvt_pk_bf16(v0[2], v0[3]); w.z = cvt_pk_bf16(v1[0], v1[1]); w.w = cvt_pk_bf16(v1[2], v1[3]);
                    *(u32x4*)(rowp + bj * HALF) = w; } }
    }
};
struct EpiResB {
    static constexpr bool PERM = true;
    bf16_t* X; const float* gate;
    __device__ __forceinline__ void operator()(const f32x4 (&acc)[2][2][4][2], const Unit& u, int wr, int wc, int fr, int fq) const {
        const int b = (u.pm < 256) ? (u.pm >> 3) : 32;
        const int row0 = u.pm * BM + wr * 64 + fr, col0 = u.pn * BM + wc * 32 + 8 * fq;
        f32x4 gv[2][2];
#pragma unroll
        for (int bj = 0; bj < 2; ++bj)
#pragma unroll
            for (int n = 0; n < 2; ++n) gv[bj][n] = *(const f32x4*)(gate + (size_t)b * (NMOD * DM) + col0 + bj * HALF + n * 4);
#pragma unroll
        for (int ai = 0; ai < 2; ++ai) {
            u32x4 xv[4][2];
#pragma unroll
            for (int m = 0; m < 4; ++m)
#pragma unroll
                for (int bj = 0; bj < 2; ++bj) xv[m][bj] = *(const u32x4*)(X + (size_t)(row0 + ai * HALF + m * 16) * DM + col0 + bj * HALF);
#pragma unroll
            for (int m = 0; m < 4; ++m)
#pragma unroll
                for (int bj = 0; bj < 2; ++bj) { const u32x4 xw = xv[m][bj]; const f32x4 a0 = acc[ai][bj][m][0] * gv[bj][0], a1 = acc[ai][bj][m][1] * gv[bj][1];
                    u32x4 w;
                    w.x = cvt_pk_bf16(__uint_as_float(xw.x << 16) + a0[0], __uint_as_float(xw.x & 0xffff0000u) + a0[1]);
                    w.y = cvt_pk_bf16(__uint_as_float(xw.y << 16) + a0[2], __uint_as_float(xw.y & 0xffff0000u) + a0[3]);
                    w.z = cvt_pk_bf16(__uint_as_float(xw.z << 16) + a1[0], __uint_as_float(xw.z & 0xffff0000u) + a1[1]);
                    w.w = cvt_pk_bf16(__uint_as_float(xw.w << 16) + a1[2], __uint_as_float(xw.w & 0xffff0000u) + a1[3]);
                    *(u32x4*)(X + (size_t)(row0 + ai * HALF + m * 16) * DM + col0 + bj * HALF) = w; } }
    }
};
struct EpiResNorm {
    static constexpr bool PERM = true;
    bf16_t* X; const float* gate; bool fuse;
    bf16_t* H; const float* gw; const float* modn; int shi, sci;
    float* xch; LAS unsigned char* tab;
    float* F; int mstride;
    __device__ __forceinline__ void operator()(f32x4 (&acc)[2][2][4][2], const Unit& u, int wr, int wc, int fr, int fq) const {
        const int b = (u.pm < 256) ? (u.pm >> 3) : 32;
        const int row0 = u.pm * BM + wr * 64 + fr, col0 = u.pn * BM + wc * 32 + 8 * fq;
        { f32x4 gv[2][2];
#pragma unroll
          for (int bj = 0; bj < 2; ++bj)
#pragma unroll
            for (int n = 0; n < 2; ++n) gv[bj][n] = *(const f32x4*)(gate + (size_t)b * (NMOD * DM) + col0 + bj * HALF + n * 4);
#pragma unroll
          for (int ai = 0; ai < 2; ++ai) {
            u32x4 xv[4][2];
#pragma unroll
            for (int m = 0; m < 4; ++m)
#pragma unroll
                for (int bj = 0; bj < 2; ++bj) xv[m][bj] = *(const u32x4*)(X + (size_t)(row0 + ai * HALF + m * 16) * DM + col0 + bj * HALF);
#pragma unroll
            for (int m = 0; m < 4; ++m)
#pragma unroll
                for (int bj = 0; bj < 2; ++bj) { const u32x4 xw = xv[m][bj]; f32x4 a0 = acc[ai][bj][m][0] * gv[bj][0], a1 = acc[ai][bj][m][1] * gv[bj][1];
                    a0[0] += __uint_as_float(xw.x << 16); a0[1] += __uint_as_float(xw.x & 0xffff0000u); a0[2] += __uint_as_float(xw.y << 16); a0[3] += __uint_as_float(xw.y & 0xffff0000u);
                    a1[0] += __uint_as_float(xw.z << 16); a1[1] += __uint_as_float(xw.z & 0xffff0000u); a1[2] += __uint_as_float(xw.w << 16); a1[3] += __uint_as_float(xw.w & 0xffff0000u);
                    acc[ai][bj][m][0] = a0; acc[ai][bj][m][1] = a1; } } }
        const int tid = threadIdx.x;
        LAS float* Pt = (LAS float*)tab; LAS float* St = (LAS float*)(tab + 4096);
        if (fuse) {
#pragma unroll
            for (int ai = 0; ai < 2; ++ai)
#pragma unroll
                for (int m = 0; m < 4; ++m) { float q = 0.f;
#pragma unroll
                    for (int bj = 0; bj < 2; ++bj)
#pragma unroll
                        for (int n = 0; n < 2; ++n) { const f32x4 x = acc[ai][bj][m][n]; q += (x[0] * x[0] + x[1] * x[1]) + (x[2] * x[2] + x[3] * x[3]); }
                    q += bperm_xor(q, 16, (fq << 4) | fr); q += bperm_xor(q, 32, (fq << 4) | fr);
                    if (fq == 0) Pt[(ai * HALF + wr * 64 + m * 16 + fr) * 4 + wc] = q; }
            asm volatile("s_waitcnt lgkmcnt(0)" ::: "memory"); __builtin_amdgcn_s_barrier(); asm volatile("" ::: "memory");
            if (tid < 256) { const float t = (Pt[tid * 4 + 0] + Pt[tid * 4 + 1]) + (Pt[tid * 4 + 2] + Pt[tid * 4 + 3]);
                __hip_atomic_store(xch + ((size_t)u.pm * BM + tid) * 4 + u.pn, t, __ATOMIC_RELAXED, __HIP_MEMORY_SCOPE_AGENT); }
        }
#pragma unroll
        for (int ai = 0; ai < 2; ++ai)
#pragma unroll
            for (int m = 0; m < 4; ++m)
#pragma unroll
                for (int bj = 0; bj < 2; ++bj) { const f32x4 a0 = acc[ai][bj][m][0], a1 = acc[ai][bj][m][1];
                    u32x4 w; w.x = cvt_pk_bf16(a0[0], a0[1]); w.y = cvt_pk_bf16(a0[2], a0[3]); w.z = cvt_pk_bf16(a1[0], a1[1]); w.w = cvt_pk_bf16(a1[2], a1[3]);
                    *(u32x4*)(X + (size_t)(row0 + ai * HALF + m * 16) * DM + col0 + bj * HALF) = w; }
        if (!fuse) return;
        if (tid < 256) { const float* sl = xch + ((size_t)u.pm * BM + tid) * 4; f32x4 v;
            for (int spin = 0; spin < (1 << 22); ++spin) {
                asm volatile("global_load_dwordx4 %0, %1, off sc1\n\ts_waitcnt vmcnt(0)" : "=&v"(v) : "v"(sl) : "memory");
                const bool ok = (v[0] >= 0.f) && (v[1] >= 0.f) && (v[2] >= 0.f) && (v[3] >= 0.f);
                if (__all(ok)) break;
                __builtin_amdgcn_s_sleep(1); }
            St[tid] = rsqrtf(((v[0] + v[1]) + (v[2] + v[3])) * (1.f / DM) + EPS); }
        asm volatile("s_waitcnt vmcnt(0) lgkmcnt(0)" ::: "memory"); __builtin_amdgcn_s_barrier(); asm volatile("" ::: "memory");
        const float* mb = modn + (size_t)b * mstride;
#pragma unroll
        for (int bj = 0; bj < 2; ++bj) { f32x4 gg[2], sc[2], sh[2];
#pragma unroll
            for (int n = 0; n < 2; ++n) { const int c = col0 + bj * HALF + n * 4; gg[n] = *(const f32x4*)(gw + c); sc[n] = *(const f32x4*)(mb + sci * DM + c) + 1.f; sh[n] = *(const f32x4*)(mb + shi * DM + c); gg[n] = gg[n] * sc[n]; }
#pragma unroll
            for (int ai = 0; ai < 2; ++ai)
#pragma unroll
                for (int m = 0; m < 4; ++m) { const float rs = St[ai * HALF + wr * 64 + m * 16 + fr];
                    const f32x4 y0 = (acc[ai][bj][m][0] * rs) * gg[0] + sh[0], y1 = (acc[ai][bj][m][1] * rs) * gg[1] + sh[1];
                    if (F) { float* op = F + (size_t)(row0 + ai * HALF + m * 16) * DM + col0 + bj * HALF; *(f32x4*)op = y0; *(f32x4*)(op + 4) = y1; }
                    else { u32x4 w; w.x = cvt_pk_bf16(y0[0], y0[1]); w.y = cvt_pk_bf16(y0[2], y0[3]); w.z = cvt_pk_bf16(y1[0], y1[1]); w.w = cvt_pk_bf16(y1[2], y1[3]);
                        *(u32x4*)(H + (size_t)(row0 + ai * HALF + m * 16) * DM + col0 + bj * HALF) = w; } } }
    }
};
struct EpiSwi {
    static constexpr bool PERM = true;
    bf16_t* O;
    __device__ __forceinline__ void operator()(const f32x4 (&acc)[2][2][4][2], const Unit& u, int wr, int wc, int fr, int fq) const {
        const int row0 = u.pm * BM + wr * 64 + fr, col0 = u.pn * HALF + wc * 32 + 8 * fq;
#pragma unroll
        for (int ai = 0; ai < 2; ++ai)
#pragma unroll
            for (int m = 0; m < 4; ++m) { float h[8];
#pragma unroll
                for (int n = 0; n < 2; ++n)
#pragma unroll
                    for (int j = 0; j < 4; ++j) { const float gt = acc[ai][0][m][n][j], up = acc[ai][1][m][n][j];
                        h[n * 4 + j] = gt * __builtin_amdgcn_rcpf(1.f + __builtin_amdgcn_exp2f(-1.4426950408889634f * gt)) * up; }
                u32x4 w; w.x = cvt_pk_bf16(h[0], h[1]); w.y = cvt_pk_bf16(h[2], h[3]); w.z = cvt_pk_bf16(h[4], h[5]); w.w = cvt_pk_bf16(h[6], h[7]);
                *(u32x4*)(O + (size_t)(row0 + ai * HALF + m * 16) * FFN + col0) = w; }
    }
};
}

namespace att {
constexpr int KVBLK = 64;
constexpr float SCALE = 0.125f, THR = 8.f;
constexpr int SHM_V = KVBLK * 128 * 2, SHM_K = KVBLK * 128 * 2;
constexpr int OX_STRIDE = 144;
constexpr int OX_BYTES = 128 * OX_STRIDE * 4;
constexpr int WSCR_OFF = 2 * OX_BYTES;
#define KSWZ(row, colB) ((row) * 256 + ((colB) ^ (((row) & 15) << 4)))
#define SBAR() __builtin_amdgcn_sched_barrier(0)
__device__ __forceinline__ int crow(int r, int hi) { return (r & 3) + 8 * (r >> 2) + 4 * hi; }

__device__ __forceinline__ void partialSM(f32x16& p0, f32x16& p1, float& m_reg, float& mn, float& alpha) {
  constexpr float C = SCALE * 1.4426950408889634f;
  float pmax = p0[0];
#pragma unroll
  for (int r = 1; r < 16; ++r) pmax = fmaxf(pmax, p0[r]);
#pragma unroll
  for (int r = 0; r < 16; ++r) pmax = fmaxf(pmax, p1[r]);
  { auto rr = __builtin_amdgcn_permlane32_swap(__float_as_uint(pmax), __float_as_uint(pmax), false, false);
    pmax = fmaxf(__uint_as_float(rr[0]), __uint_as_float(rr[1])); }
  if (__builtin_expect(__all(pmax - m_reg <= THR / SCALE), 1)) { mn = m_reg; alpha = 1.f; }
  else { mn = fmaxf(m_reg, pmax); alpha = __builtin_amdgcn_exp2f((m_reg - mn) * C); m_reg = mn; }
  float mnC = -mn * C;
#pragma unroll
  for (int r = 0; r < 16; ++r) p0[r] = fmaf(p0[r], C, mnC);
#pragma unroll
  for (int r = 0; r < 16; ++r) p1[r] = fmaf(p1[r], C, mnC);
#pragma unroll
  for (int r = 0; r < 16; ++r) p0[r] = __builtin_amdgcn_exp2f(p0[r]);
}
__device__ __forceinline__ void finishSM(f32x16& p0, f32x16& p1, float alpha, float& l_reg, bf16x8& pa0, bf16x8& pa1, bf16x8& pa2, bf16x8& pa3) {
#pragma unroll
  for (int r = 0; r < 16; ++r) p1[r] = __builtin_amdgcn_exp2f(p1[r]);
  float ps = 0;
#pragma unroll
  for (int r = 0; r < 16; ++r) ps += p0[r];
#pragma unroll
  for (int r = 0; r < 16; ++r) ps += p1[r];
  { auto rr = __builtin_amdgcn_permlane32_swap(__float_as_uint(ps), __float_as_uint(ps), false, false);
    ps = __uint_as_float(rr[0]) + __uint_as_float(rr[1]); }
  l_reg = l_reg * alpha + ps;
#define PKB(P, BASE, OUT) do { u32x4 w = {cvt_pk_bf16(P[BASE + 0], P[BASE + 1]), cvt_pk_bf16(P[BASE + 2], P[BASE + 3]), cvt_pk_bf16(P[BASE + 4], P[BASE + 5]), cvt_pk_bf16(P[BASE + 6], P[BASE + 7])}; \
    OUT = *reinterpret_cast<bf16x8*>(&w); } while (0)
  PKB(p0, 0, pa0); PKB(p0, 8, pa1); PKB(p1, 0, pa2); PKB(p1, 8, pa3);
#undef PKB
}
__device__ __forceinline__ void qkt(f32x16& p0, f32x16& p1, const char* Ks, const bf16x8* qr, int r32, int hi, int cmapB) {
  p0 = f32x16{}; p1 = f32x16{};
#pragma unroll
  for (int d0 = 0; d0 < 4; ++d0) { int cb = cmapB + (d0 * 16 + hi * 8) * 2;
    bf16x8 b0 = *reinterpret_cast<const bf16x8*>(Ks + KSWZ(r32, cb));
    bf16x8 b1 = *reinterpret_cast<const bf16x8*>(Ks + KSWZ(32 + r32, cb));
    p0 = __builtin_amdgcn_mfma_f32_32x32x16_bf16(b0, qr[d0], p0, 0, 0, 0);
    p1 = __builtin_amdgcn_mfma_f32_32x32x16_bf16(b1, qr[d0], p1, 0, 0, 0); }
}
__device__ __forceinline__ int v_st(int k, int c) { const int kk = k;     return ((kk >> 3) * 4 + (c >> 5)) * 512 + ((kk & 7) * 32 + (c & 31)) * 2; }
__device__ __forceinline__ int v_rd_base(int lane) { return ((lane & 3) << 3) | (((lane >> 2) & 3) << 6) | (((lane >> 4) & 1) << 5) | (((lane >> 5) & 1) << 8); }
constexpr int v_rd_off(int d0, int ks, int half) { return d0 * 512 + ks * 4096 + half * 2048; }
template <int OFF> __device__ __forceinline__ s16x4 tr_read(int vb) {
  s16x4 r; asm volatile("ds_read_b64_tr_b16 %0, %1 offset:%2" : "=&v"(r) : "v"(vb), "i"(OFF) : "memory"); return r;
}
template <int D0> __device__ __forceinline__ void pv_one(f32x16& od, int vb, bf16x8 pa0, bf16x8 pa1, bf16x8 pa2, bf16x8 pa3) {
  const s16x4 l0 = tr_read<v_rd_off(D0, 0, 0)>(vb), h0 = tr_read<v_rd_off(D0, 0, 1)>(vb), l1 = tr_read<v_rd_off(D0, 1, 0)>(vb), h1 = tr_read<v_rd_off(D0, 1, 1)>(vb);
  const s16x4 l2 = tr_read<v_rd_off(D0, 2, 0)>(vb), h2 = tr_read<v_rd_off(D0, 2, 1)>(vb), l3 = tr_read<v_rd_off(D0, 3, 0)>(vb), h3 = tr_read<v_rd_off(D0, 3, 1)>(vb);
  asm volatile("s_waitcnt lgkmcnt(0)" ::: "memory"); SBAR();
#define PK(L, H) (bf16x8){L[0], L[1], L[2], L[3], H[0], H[1], H[2], H[3]}
  od = __builtin_amdgcn_mfma_f32_32x32x16_bf16(PK(l0, h0), pa0, od, 0, 0, 0);
  od = __builtin_amdgcn_mfma_f32_32x32x16_bf16(PK(l1, h1), pa1, od, 0, 0, 0);
  od = __builtin_amdgcn_mfma_f32_32x32x16_bf16(PK(l2, h2), pa2, od, 0, 0, 0);
  od = __builtin_amdgcn_mfma_f32_32x32x16_bf16(PK(l3, h3), pa3, od, 0, 0, 0);
#undef PK
}
__device__ __forceinline__ void pv_d0(f32x16* o, int vb, bf16x8 pa0, bf16x8 pa1, bf16x8 pa2, bf16x8 pa3) {
  pv_one<0>(o[0], vb, pa0, pa1, pa2, pa3); pv_one<1>(o[1], vb, pa0, pa1, pa2, pa3); pv_one<2>(o[2], vb, pa0, pa1, pa2, pa3); pv_one<3>(o[3], vb, pa0, pa1, pa2, pa3);
}

__device__ __forceinline__ void pv_sm(f32x16* o, int vb, bf16x8 pa0, bf16x8 pa1, bf16x8 pa2, bf16x8 pa3, f32x16& p0, f32x16& p1, float& m_reg, float& mn, float& alpha) {
  constexpr float C = SCALE * 1.4426950408889634f;
  pv_one<0>(o[0], vb, pa0, pa1, pa2, pa3);
  float mx0 = p0[0];
#pragma unroll
  for (int r = 1; r < 16; ++r) mx0 = fmaxf(mx0, p0[r]);
  pv_one<1>(o[1], vb, pa0, pa1, pa2, pa3);
  float pmax = mx0;
#pragma unroll
  for (int r = 0; r < 16; ++r) pmax = fmaxf(pmax, p1[r]);
  { auto rr = __builtin_amdgcn_permlane32_swap(__float_as_uint(pmax), __float_as_uint(pmax), false, false);
    pmax = fmaxf(__uint_as_float(rr[0]), __uint_as_float(rr[1])); }
  if (__builtin_expect(__all(pmax - m_reg <= THR / SCALE), 1)) { mn = m_reg; alpha = 1.f; }
  else { mn = fmaxf(m_reg, pmax); alpha = __builtin_amdgcn_exp2f((m_reg - mn) * C); m_reg = mn; }
  const float mnC = -mn * C;
  pv_one<2>(o[2], vb, pa0, pa1, pa2, pa3);
#pragma unroll
  for (int r = 0; r < 16; ++r) p0[r] = fmaf(p0[r], C, mnC);
#pragma unroll
  for (int r = 0; r < 16; ++r) p1[r] = fmaf(p1[r], C, mnC);
#pragma unroll
  for (int r = 0; r < 8; ++r) p0[r] = __builtin_amdgcn_exp2f(p0[r]);
  pv_one<3>(o[3], vb, pa0, pa1, pa2, pa3);
#pragma unroll
  for (int r = 8; r < 16; ++r) p0[r] = __builtin_amdgcn_exp2f(p0[r]);
}

__device__ __forceinline__ void attn_item(const bf16_t* __restrict__ proj, bf16_t* __restrict__ mix, int qrow0, int h, int crow0, int lrow0, int NT,
                                       float lam, float postscale, const float* __restrict__ gsub, char* lds) {
  const int tid = opaque_tid(), wid = tid >> 6, lane = tid & 63, r32 = lane & 31, hi = lane >> 5;
  const int cmap = wid >> 2, wq = wid & 3, cmapB = cmap * 128;
  char* V_lds = lds; char* K_lds = lds + 2 * SHM_V;
  float* wsx = (float*)(lds + WSCR_OFF) + wid * 64; float* li_l = wsx; float* al_l = wsx + 32;
  float m_reg = -1e30f, l_reg = 0; f32x16 o[4] = {}; bf16x8 qr[4];
  const bf16_t* Qw = proj + (size_t)(qrow0 + wq * 32 + r32) * INC + h * 128 + cmap * 64 + hi * 8;
#pragma unroll
  for (int d0 = 0; d0 < 4; ++d0) qr[d0] = *reinterpret_cast<const bf16x8*>(Qw + d0 * 16);
  const int sr = tid >> 4, sc = (tid & 15) * 8, vst0 = v_st(sr, sc), vst1 = v_st(32 + sr, sc);
  const int vb0 = (int)(uintptr_t)V_lds + v_rd_base(lane);
  const bf16_t* Kbase = proj + 512 + h * 128 + sc; const bf16_t* Vbase = proj + 1024 + h * 128 + sc;
  struct { bf16x8 vs0, vs1, ks0, ks1; } sr_[2];
#define KROW(k0) ((k0) < 256 ? crow0 + (k0) : lrow0 + (k0) - 256)
#define SLOAD(i, k0) do { const size_t _r0 = (size_t)(KROW(k0) + sr) * INC, _r1 = _r0 + (size_t)32 * INC; \
    sr_[i].vs0 = *reinterpret_cast<const bf16x8*>(Vbase + _r0); sr_[i].vs1 = *reinterpret_cast<const bf16x8*>(Vbase + _r1); \
    sr_[i].ks0 = *reinterpret_cast<const bf16x8*>(Kbase + _r0); sr_[i].ks1 = *reinterpret_cast<const bf16x8*>(Kbase + _r1); } while (0)
#define SWRITE(b, i) do { *(bf16x8*)(V_lds + (b) * SHM_V + vst0) = sr_[i].vs0;          \
    *(bf16x8*)(V_lds + (b) * SHM_V + vst1) = sr_[i].vs1; int kc = sc * 2;               \
    *(bf16x8*)(K_lds + (b) * SHM_K + KSWZ(sr, kc)) = sr_[i].ks0;                       \
    *(bf16x8*)(K_lds + (b) * SHM_K + KSWZ(32 + sr, kc)) = sr_[i].ks1; } while (0)
#define SWAIT() asm volatile("s_waitcnt vmcnt(4)" ::: "memory")
#define RESC(a) do { if (__any((a) < 1.f)) { \
    _Pragma("unroll") for (int d = 0; d < 4; ++d) _Pragma("unroll") for (int r = 0; r < 16; ++r) o[d][r] *= (a); } } while (0)
  f32x16 pA0, pA1, pB0, pB1; float mnA, mnB, alA, alB; bf16x8 pa0, pa1, pa2, pa3;
  constexpr int SE = 0, SO = 1;
  SLOAD(SE, 0); SLOAD(SO, KVBLK);
  SWRITE(0, SE); SLOAD(SE, 2 * KVBLK); __syncthreads();
  qkt(pA0, pA1, K_lds, qr, r32, hi, cmapB); partialSM(pA0, pA1, m_reg, mnA, alA);
  SWAIT(); SWRITE(1, SO); __syncthreads();
  for (int j = 1; j + 1 < NT; j += 2) {
    SBAR(); qkt(pB0, pB1, K_lds + SHM_K, qr, r32, hi, cmapB);
    finishSM(pA0, pA1, alA, l_reg, pa0, pa1, pa2, pa3); SBAR();
    SLOAD(SO, (j + 2) * KVBLK); SBAR();
    pv_sm(o, vb0, pa0, pa1, pa2, pa3, pB0, pB1, m_reg, mnB, alB);
    __syncthreads(); SWAIT(); SWRITE(0, SE);
    RESC(alB); __syncthreads();
    SBAR(); qkt(pA0, pA1, K_lds, qr, r32, hi, cmapB);
    finishSM(pB0, pB1, alB, l_reg, pa0, pa1, pa2, pa3); SBAR();
    SLOAD(SE, (j + 3 < NT ? j + 3 : NT - 1) * KVBLK); SBAR();
    pv_sm(o, vb0 + SHM_V, pa0, pa1, pa2, pa3, pA0, pA1, m_reg, mnA, alA);
    __syncthreads(); SWAIT(); SWRITE(1, SO);
    RESC(alA); __syncthreads();
  }
  SBAR(); qkt(pB0, pB1, K_lds + SHM_K, qr, r32, hi, cmapB);
  finishSM(pA0, pA1, alA, l_reg, pa0, pa1, pa2, pa3); SBAR();
  pv_sm(o, vb0, pa0, pa1, pa2, pa3, pB0, pB1, m_reg, mnB, alB);
  __syncthreads(); RESC(alB);
  finishSM(pB0, pB1, alB, l_reg, pa0, pa1, pa2, pa3); SBAR();
  pv_d0(o, vb0 + SHM_V, pa0, pa1, pa2, pa3);
  const float rl = __builtin_amdgcn_rcpf(l_reg) * (cmap ? lam : 1.f);
  __syncthreads();
  float* OX = (float*)(lds + cmap * OX_BYTES) + (wq * 32 + r32) * OX_STRIDE + 4 * hi;
#pragma unroll
  for (int d0 = 0; d0 < 4; ++d0)
#pragma unroll
    for (int rg = 0; rg < 4; ++rg) { const f32x4 v = {o[d0][4 * rg + 0] * rl, o[d0][4 * rg + 1] * rl, o[d0][4 * rg + 2] * rl, o[d0][4 * rg + 3] * rl};
      *(f32x4*)(OX + d0 * 32 + 8 * rg) = v; }
  __syncthreads();
  { const int row = tid >> 2, q = tid & 3; const float* A = (const float*)lds + row * OX_STRIDE; const float* Bm = (const float*)(lds + OX_BYTES) + row * OX_STRIDE;
    f32x4 a[8]; float ss = 0.f;
#pragma unroll
    for (int i = 0; i < 8; ++i) { const int c4 = 4 * (q + 4 * i); a[i] = *(const f32x4*)(A + c4) - *(const f32x4*)(Bm + c4);
      ss += a[i][0] * a[i][0] + a[i][1] * a[i][1] + a[i][2] * a[i][2] + a[i][3] * a[i][3]; }
    ss += bperm_xor(ss, 1, lane); ss += bperm_xor(ss, 2, lane);
    const float rs = rsqrtf(ss * (1.f / 128.f) + EPS) * postscale;
    bf16_t* op = mix + (size_t)(qrow0 + row) * DM + h * 128;
#pragma unroll
    for (int i = 0; i < 8; ++i) { const int c4 = 4 * (q + 4 * i); const f32x4 g4 = *(const f32x4*)(gsub + c4); const f32x4 v = a[i] * g4 * rs;
      u32x2 w; w.x = cvt_pk_bf16(v[0], v[1]); w.y = cvt_pk_bf16(v[2], v[3]); *(u32x2*)(op + c4) = w; } }
  __syncthreads();
#undef KROW
#undef SLOAD
#undef SWRITE
#undef SWAIT
#undef RESC
}
}

__device__ __forceinline__ float bf2f(unsigned short b) { return __uint_as_float(((unsigned)b) << 16); }
__device__ __forceinline__ void unpack8(const bf16x8 v, float* f) {
#pragma unroll
  for (int j = 0; j < 8; ++j) f[j] = bf2f((unsigned short)v[j]);
}
__device__ __forceinline__ void mixer_item(const bf16_t* __restrict__ proj, bf16_t* __restrict__ mix, int rb, int p0, int Ls,
                                        const float* __restrict__ wconv, const bf16_t* __restrict__ wpoolT, const float* __restrict__ spool, char* lds) {
  const int tid = opaque_tid();
  constexpr int HS = 528;
  char* HT = lds;
  char* PT = lds + 80 * HS;
  bf16x8 hv[5];
#pragma unroll
  for (int k = 0; k < 5; ++k) { const int id = tid + k * NTHREADS; const int rr = id >> 5, ch = (id & 31) * 8; const int p = p0 - 8 + rr;
    hv[k] = (bf16x8){0, 0, 0, 0, 0, 0, 0, 0};
    if (id < 79 * 32 && p >= 0 && p < Ls) hv[k] = *reinterpret_cast<const bf16x8*>(proj + (size_t)(rb - 8 + rr) * INC + 2304 + ch); }
  bf16x8 rbg[4], ru0[4], rum[4], rup[4];
#pragma unroll
  for (int k = 0; k < 4; ++k) { const int id = tid + k * NTHREADS; const int tok = id >> 5, ch = (id & 31) * 8; const int p = p0 + tok;
    const bf16_t* rp = proj + (size_t)(rb + tok) * INC + 1536 + ch;
    const bf16_t* rm = (p > 0) ? rp - INC : rp; const bf16_t* rq = (p + 1 < Ls) ? rp + INC : rp;
    rbg[k] = *reinterpret_cast<const bf16x8*>(rp); ru0[k] = *reinterpret_cast<const bf16x8*>(rp + 256);
    rum[k] = *reinterpret_cast<const bf16x8*>(rm + 256); rup[k] = *reinterpret_cast<const bf16x8*>(rq + 256); }
#pragma unroll
  for (int k = 0; k < 5; ++k) { const int id = tid + k * NTHREADS; const int rr = id >> 5, ch = (id & 31) * 8;
    if (id < 79 * 32) *(bf16x8*)(HT + rr * HS + ch * 2) = hv[k]; }
#pragma unroll
  for (int k = 0; k < 4; ++k) { const int id = tid + k * NTHREADS; const int tok = id >> 5, ch = (id & 31) * 8; const int p = p0 + tok;
    float bg[8], um[8], u0[8], up[8], w0[8], w1[8], w2[8];
    unpack8(rbg[k], bg); unpack8(ru0[k], u0); unpack8(rum[k], um); unpack8(rup[k], up);
#pragma unroll
    for (int q = 0; q < 2; ++q) { const f32x4 a0 = *(const f32x4*)(wconv + ch + q * 4), a1 = *(const f32x4*)(wconv + 256 + ch + q * 4), a2 = *(const f32x4*)(wconv + 512 + ch + q * 4);
#pragma unroll
      for (int e = 0; e < 4; ++e) { w0[q * 4 + e] = a0[e]; w1[q * 4 + e] = a1[e]; w2[q * 4 + e] = a2[e]; } }
    const float fm = (p > 0) ? 1.f : 0.f, fp = (p + 1 < Ls) ? 1.f : 0.f;
    float y[8];
#pragma unroll
    for (int j = 0; j < 8; ++j) y[j] = bg[j] * (fm * um[j] * w0[j] + u0[j] * w1[j] + fp * up[j] * w2[j]);
    u32x4 w; w.x = cvt_pk_bf16(y[0], y[1]); w.y = cvt_pk_bf16(y[2], y[3]); w.z = cvt_pk_bf16(y[4], y[5]); w.w = cvt_pk_bf16(y[6], y[7]);
    *(u32x4*)(mix + (size_t)(rb + tok) * DM + 512 + ch) = w; }
  __syncthreads();
#pragma unroll
  for (int g = 0; g < 4; ++g) { const int hw = 1 << g; const int tok = tid >> 3, c0 = g * 64 + (tid & 7) * 8, colb = c0 * 2; const int p = p0 + tok;
    float sm[8] = {0.f, 0.f, 0.f, 0.f, 0.f, 0.f, 0.f, 0.f};
#pragma unroll
    for (int q = -hw; q < hw; ++q) { float f[8]; unpack8(*(const bf16x8*)(HT + (tok + 8 + q) * HS + colb), f);
#pragma unroll
      for (int j = 0; j < 8; ++j) sm[j] += f[j]; }
    int lo = p - hw, hi2 = p + hw - 1; if (lo < 0) lo = 0; if (hi2 > Ls - 1) hi2 = Ls - 1;
    float self[8]; unpack8(*(const bf16x8*)(HT + (tok + 8) * HS + colb), self);
    const float inv = 1.f / (float)(hi2 - lo + 1);
    const f32x4 s0 = *(const f32x4*)(spool + c0), s1 = *(const f32x4*)(spool + c0 + 4);
    float y[8];
#pragma unroll
    for (int j = 0; j < 4; ++j) { y[j] = (sm[j] * inv - self[j]) * s0[j]; y[4 + j] = (sm[4 + j] * inv - self[4 + j]) * s1[j]; }
    u32x4 w; w.x = cvt_pk_bf16(y[0], y[1]); w.y = cvt_pk_bf16(y[2], y[3]); w.z = cvt_pk_bf16(y[4], y[5]); w.w = cvt_pk_bf16(y[6], y[7]);
    *(u32x4*)(mix + (size_t)(rb + tok) * DM + 768 + c0) = w; }
  __syncthreads();
}

__device__ __forceinline__ float wave_sum(float v, int lane) {
#pragma unroll
  for (int o = 32; o >= 1; o >>= 1) v += bperm_xor(v, o, lane);
  return v;
}
__device__ __forceinline__ void unpack_bf8(const u32x4 w, float* f) {
  f[0] = __uint_as_float(w.x << 16); f[1] = __uint_as_float(w.x & 0xffff0000u); f[2] = __uint_as_float(w.y << 16); f[3] = __uint_as_float(w.y & 0xffff0000u);
  f[4] = __uint_as_float(w.z << 16); f[5] = __uint_as_float(w.z & 0xffff0000u); f[6] = __uint_as_float(w.w << 16); f[7] = __uint_as_float(w.w & 0xffff0000u);
}
__device__ __forceinline__ u32x4 pack_bf8(const float* f) { u32x4 w; w.x = cvt_pk_bf16(f[0], f[1]); w.y = cvt_pk_bf16(f[2], f[3]); w.z = cvt_pk_bf16(f[4], f[5]); w.w = cvt_pk_bf16(f[6], f[7]); return w; }
template <bool F32SRC>
__device__ __forceinline__ void norm_phase(const float* xlat, const float* xctx, bf16_t* xb, const float* g, const float* modl, int shi, int sci, bf16_t* act, int nrows) {
  constexpr int NRW = F32SRC ? 4 : 8;
  const int tid = opaque_tid(); const int lane = tid & 63; const int gw = blockIdx.x * 8 + (tid >> 6), nw = gridDim.x * 8;
  const int rpw = (nrows + nw - 1) / nw; const int r0 = gw * rpw; const int r1 = (r0 + rpw < nrows) ? r0 + rpw : nrows;
  float gg[16], scv[16], shv[16];
#pragma unroll
  for (int i = 0; i < 2; ++i)
#pragma unroll
    for (int q = 0; q < 2; ++q) { const f32x4 t = *(const f32x4*)(g + i * 512 + lane * 8 + q * 4); gg[i * 8 + q * 4 + 0] = t[0]; gg[i * 8 + q * 4 + 1] = t[1]; gg[i * 8 + q * 4 + 2] = t[2]; gg[i * 8 + q * 4 + 3] = t[3]; }
#pragma unroll
  for (int k = 0; k < 16; ++k) { scv[k] = 0.f; shv[k] = 0.f; }
  int bcur = -1;
#pragma unroll 1
  for (int rb = r0; rb < r1; rb += NRW) {
    u32x4 raw[NRW][2]; f32x4 rawf[F32SRC ? NRW : 1][4];
#pragma unroll
    for (int j = 0; j < NRW; ++j) { const int r = rb + j;
      if (F32SRC) {
#pragma unroll
        for (int i = 0; i < 4; ++i) rawf[F32SRC ? j : 0][i] = (f32x4){0.f, 0.f, 0.f, 0.f};
        if (r < r1) { const float* src = (r < MLAT) ? xlat + (size_t)r * DM : xctx + (size_t)(r - MLAT) * DM;
#pragma unroll
          for (int i = 0; i < 4; ++i) rawf[F32SRC ? j : 0][i] = *(const f32x4*)(src + (i >> 1) * 512 + lane * 8 + (i & 1) * 4); }
      } else {
        raw[j][0] = (u32x4){0u, 0u, 0u, 0u}; raw[j][1] = raw[j][0];
        if (r < r1) { raw[j][0] = *(const u32x4*)(xb + (size_t)r * DM + lane * 8); raw[j][1] = *(const u32x4*)(xb + (size_t)r * DM + 512 + lane * 8); } } }
#pragma unroll
    for (int j = 0; j < NRW; ++j) { const int r = rb + j; float v[16];
      if (F32SRC) {
#pragma unroll
        for (int i = 0; i < 4; ++i) { const f32x4 t = rawf[F32SRC ? j : 0][i]; v[i * 4 + 0] = t[0]; v[i * 4 + 1] = t[1]; v[i * 4 + 2] = t[2]; v[i * 4 + 3] = t[3]; }
      } else { unpack_bf8(raw[j][0], v); unpack_bf8(raw[j][1], v + 8); }
      float ss = 0.f;
#pragma unroll
      for (int k = 0; k < 16; ++k) ss += v[k] * v[k];
      const float rs = rsqrtf(wave_sum(ss, lane) * (1.f / DM) + EPS);
      if (r < r1) { const int b = (r < MLAT) ? (r >> 11) : 32;
        if (b != bcur) { bcur = b; const float* mb = modl + (size_t)b * (NMOD * DM);
#pragma unroll
          for (int i = 0; i < 2; ++i)
#pragma unroll
            for (int q = 0; q < 2; ++q) { const f32x4 t = *(const f32x4*)(mb + sci * DM + i * 512 + lane * 8 + q * 4), u = *(const f32x4*)(mb + shi * DM + i * 512 + lane * 8 + q * 4);
#pragma unroll
              for (int e = 0; e < 4; ++e) { scv[i * 8 + q * 4 + e] = t[e] + 1.f; shv[i * 8 + q * 4 + e] = u[e]; } } }
        if (F32SRC) { *(u32x4*)(xb + (size_t)r * DM + lane * 8) = pack_bf8(v); *(u32x4*)(xb + (size_t)r * DM + 512 + lane * 8) = pack_bf8(v + 8); }
        float y[16];
#pragma unroll
        for (int k = 0; k < 16; ++k) y[k] = (v[k] * rs) * gg[k] * scv[k] + shv[k];
        *(u32x4*)(act + (size_t)r * DM + lane * 8) = pack_bf8(y); *(u32x4*)(act + (size_t)r * DM + 512 + lane * 8) = pack_bf8(y + 8); } }
  }
}
__device__ __forceinline__ void final_norm(const bf16_t* xb, float* out, const float* g) {
  constexpr int NRW = 8;
  const int tid = opaque_tid(); const int lane = tid & 63; const int gw = blockIdx.x * 8 + (tid >> 6), nw = gridDim.x * 8;
  const int rpw = (MLAT + nw - 1) / nw; const int r0 = gw * rpw; const int r1 = (r0 + rpw < MLAT) ? r0 + rpw : MLAT;
  float gg[16];
#pragma unroll
  for (int i = 0; i < 2; ++i)
#pragma unroll
    for (int q = 0; q < 2; ++q) { const f32x4 t = *(const f32x4*)(g + i * 512 + lane * 8 + q * 4); gg[i * 8 + q * 4 + 0] = t[0]; gg[i * 8 + q * 4 + 1] = t[1]; gg[i * 8 + q * 4 + 2] = t[2]; gg[i * 8 + q * 4 + 3] = t[3]; }
#pragma unroll 1
  for (int rb = r0; rb < r1; rb += NRW) {
    u32x4 raw[NRW][2];
#pragma unroll
    for (int j = 0; j < NRW; ++j) { const int r = rb + j; raw[j][0] = (u32x4){0u, 0u, 0u, 0u}; raw[j][1] = raw[j][0];
      if (r < r1) { raw[j][0] = *(const u32x4*)(xb + (size_t)r * DM + lane * 8); raw[j][1] = *(const u32x4*)(xb + (size_t)r * DM + 512 + lane * 8); } }
#pragma unroll
    for (int j = 0; j < NRW; ++j) { const int r = rb + j; float v[16]; unpack_bf8(raw[j][0], v); unpack_bf8(raw[j][1], v + 8);
      float ss = 0.f;
#pragma unroll
      for (int k = 0; k < 16; ++k) ss += v[k] * v[k];
      const float rs = rsqrtf(wave_sum(ss, lane) * (1.f / DM) + EPS);
      if (r < r1) {
#pragma unroll
        for (int i = 0; i < 2; ++i)
#pragma unroll
          for (int q = 0; q < 2; ++q) { f32x4 o; o[0] = v[i * 8 + q * 4 + 0] * rs * gg[i * 8 + q * 4 + 0]; o[1] = v[i * 8 + q * 4 + 1] * rs * gg[i * 8 + q * 4 + 1];
            o[2] = v[i * 8 + q * 4 + 2] * rs * gg[i * 8 + q * 4 + 2]; o[3] = v[i * 8 + q * 4 + 3] * rs * gg[i * 8 + q * 4 + 3];
            *(f32x4*)(out + (size_t)r * DM + i * 512 + lane * 8 + q * 4) = o; } } }
  }
}
__device__ __forceinline__ void transpose_tile(const float* src, int ldS, bf16_t* dst, int ldD, int k0, int n0s, int n0d, float* tile) {
  const int tid = opaque_tid();
  { const int i = tid >> 3, j0 = (tid & 7) * 8; const float* p = src + (size_t)(k0 + i) * ldS + n0s + j0;
    const f32x4 a = *(const f32x4*)p, b = *(const f32x4*)(p + 4); float* t = tile + i * 65 + j0;
    t[0] = a[0]; t[1] = a[1]; t[2] = a[2]; t[3] = a[3]; t[4] = b[0]; t[5] = b[1]; t[6] = b[2]; t[7] = b[3]; }
  __syncthreads();
  { const int n = tid >> 3, kk0 = (tid & 7) * 8; float v[8];
#pragma unroll
    for (int j = 0; j < 8; ++j) v[j] = tile[(kk0 + j) * 65 + n];
    u32x4 w; w.x = cvt_pk_bf16(v[0], v[1]); w.y = cvt_pk_bf16(v[2], v[3]); w.z = cvt_pk_bf16(v[4], v[5]); w.w = cvt_pk_bf16(v[6], v[7]);
    *(u32x4*)(dst + (size_t)(n0d + n) * ldD + k0 + kk0) = w; }
  __syncthreads();
}
__device__ __forceinline__ void mod_item(const float* c, const float* cctx, const float* wada_l, const float* bada_l, float* mod_l, int n0, float* lds) {
  const int tid = opaque_tid();
  for (int i = tid; i < 33 * DM; i += NTHREADS) { const float v = (i < 32 * DM) ? c[i] : cctx[i - 32 * DM]; lds[i] = v / (1.f + __expf(-v)); }
  __syncthreads();
  const int col = tid & 127, kq = tid >> 7;
  float acc[33];
#pragma unroll
  for (int b = 0; b < 33; ++b) acc[b] = 0.f;
  const float* wp = wada_l + (size_t)(kq * 256) * (NMOD * DM) + n0 + col;
#pragma unroll 1
  for (int k = 0; k < 256; k += 8) {
    float w[8];
#pragma unroll
    for (int i = 0; i < 8; ++i) w[i] = wp[(size_t)(k + i) * (NMOD * DM)];
#pragma unroll
    for (int b = 0; b < 33; ++b) { const f32x4 s = *(const f32x4*)(lds + b * DM + kq * 256 + k), t = *(const f32x4*)(lds + b * DM + kq * 256 + k + 4);
      acc[b] += s[0] * w[0] + s[1] * w[1] + s[2] * w[2] + s[3] * w[3] + t[0] * w[4] + t[1] * w[5] + t[2] * w[6] + t[3] * w[7]; }
  }
  __syncthreads();
#pragma unroll
  for (int b = 0; b < 33; ++b) lds[(kq * 33 + b) * 128 + col] = acc[b];
  __syncthreads();
  for (int o = tid; o < 33 * 128; o += NTHREADS) { const int b = o >> 7, cc = o & 127;
    mod_l[(size_t)b * (NMOD * DM) + n0 + cc] = lds[(0 * 33 + b) * 128 + cc] + lds[(1 * 33 + b) * 128 + cc] + lds[(2 * 33 + b) * 128 + cc] + lds[(3 * 33 + b) * 128 + cc] + bada_l[n0 + cc]; }
  __syncthreads();
}

__device__ __forceinline__ void grid_bar(unsigned* ctr, unsigned target) {
  __syncthreads();
  if (threadIdx.x == 0) {
    __builtin_amdgcn_fence(__ATOMIC_RELEASE, "agent");
    asm volatile("s_waitcnt vmcnt(0)" ::: "memory");
    __hip_atomic_fetch_add(ctr, 1u, __ATOMIC_RELAXED, __HIP_MEMORY_SCOPE_AGENT);
    while (__hip_atomic_load(ctr, __ATOMIC_RELAXED, __HIP_MEMORY_SCOPE_AGENT) < target) __builtin_amdgcn_s_sleep(2);
    __builtin_amdgcn_fence(__ATOMIC_ACQUIRE, "agent");
    asm volatile("s_waitcnt vmcnt(0)" ::: "memory");
  }
  __syncthreads();
}
__global__ void __launch_bounds__(NTHREADS, 2) fwd_megakernel(Params P) {
  extern __shared__ __attribute__((aligned(16))) unsigned char lds[];
  cg::grid_group grid = cg::this_grid();
  const int tid = threadIdx.x, G = gridDim.x, bid = blockIdx.x;
  unsigned char* ws = P.ws;
  bf16_t* H2 = (bf16_t*)(ws + WS_H2); float* XCH = (float*)(ws + WS_XCH); unsigned* CNT = (unsigned*)(ws + WS_CNT);
  bf16_t* XB = (bf16_t*)(ws + WS_XB); bf16_t* ACT = (bf16_t*)(ws + WS_ACT); bf16_t* PROJ = (bf16_t*)(ws + WS_PROJ);
  bf16_t* WB = (bf16_t*)(ws + WS_W); bf16_t* WPOOL = (bf16_t*)(ws + WS_WPOOL); float* MOD = (float*)(ws + WS_MOD);
  float* ROPE = (float*)(ws + WS_ROPE); float* LAMV = (float*)(ws + WS_LAM);
  const float* x_in = P.in[0]; const float* ctx_in = P.in[2];

  for (int rep = 0; rep < ((DUP & 8) ? 2 : 1); ++rep)
  if constexpr (EN(0)) {
    constexpr int TILES_L = 640 + 256 + 1408 + 704 + 4;
    const int nItems = 192 + DEPTH * TILES_L + 1;
    for (int it = bid; it < nItems; it += G) {
      if (it < 192) { const int l = it / 48, nb = it % 48;
        mod_item(P.in[1], P.in[3], P.in[4] + (size_t)l * DM * NMOD * DM, P.in[5] + (size_t)l * NMOD * DM, MOD + (size_t)l * 33 * NMOD * DM, nb * 128, (float*)lds);
      } else if (it < 192 + DEPTH * TILES_L) {
        const int t = it - 192; const int l = t / TILES_L; int r = t % TILES_L; bf16_t* wl = WB + (size_t)l * W_LAYER_E; float* tile = (float*)lds;
        if (r < 640 && (r % 40) >= 36) {
          const int g = (r % 40) - 36, k0 = (r / 40) * 64; const int i = tid >> 3, j0 = (tid & 7) * 8; float* At = tile; float* Wt = tile + 64 * 65;
          { const float* pa = P.in[7] + (size_t)l * DM * INC + (size_t)(k0 + i) * INC + 2304 + g * 64 + j0; const float* pw = P.in[14] + (size_t)(l * 4 + g) * 4096 + i * 64 + j0;
            const f32x4 a0 = *(const f32x4*)pa, a1 = *(const f32x4*)(pa + 4), w0 = *(const f32x4*)pw, w1 = *(const f32x4*)(pw + 4);
#pragma unroll
            for (int e = 0; e < 4; ++e) { At[i * 65 + j0 + e] = a0[e]; At[i * 65 + j0 + 4 + e] = a1[e]; Wt[i * 64 + j0 + e] = w0[e]; Wt[i * 64 + j0 + 4 + e] = w1[e]; } }
          __syncthreads();
          float o[8] = {0.f, 0.f, 0.f, 0.f, 0.f, 0.f, 0.f, 0.f};
          for (int c = 0; c < 64; ++c) { const float a = At[i * 65 + c]; const f32x4 w0 = *(const f32x4*)(Wt + c * 64 + j0), w1 = *(const f32x4*)(Wt + c * 64 + j0 + 4);
#pragma unroll
            for (int e = 0; e < 4; ++e) { o[e] += a * w0[e]; o[4 + e] += a * w1[e]; } }
          __syncthreads();
#pragma unroll
          for (int e = 0; e < 8; ++e) At[i * 65 + j0 + e] = o[e];
          __syncthreads();
          { const int n = tid >> 3, kk0 = (tid & 7) * 8; float v[8];
#pragma unroll
            for (int j = 0; j < 8; ++j) v[j] = At[(kk0 + j) * 65 + n];
            u32x4 w; w.x = cvt_pk_bf16(v[0], v[1]); w.y = cvt_pk_bf16(v[2], v[3]); w.z = cvt_pk_bf16(v[4], v[5]); w.w = cvt_pk_bf16(v[6], v[7]);
            *(u32x4*)(wl + (size_t)(2304 + g * 64 + n) * DM + k0 + kk0) = w; }
          __syncthreads();
        } else if (r < 640) { const int n0 = (r % 40) * 64; int nd = n0;
          if (n0 >= 1792 && n0 < 2304) { const int xin = n0 >= 2048; const int c = n0 - (xin ? 2048 : 1792); nd = 1792 + (c / 128) * 256 + (xin ? 128 : 0) + (c % 128); }
          transpose_tile(P.in[7] + (size_t)l * DM * INC, INC, wl, DM, (r / 40) * 64, n0, nd, tile); }
        else if ((r -= 640) < 256) { transpose_tile(P.in[16] + (size_t)l * DM * DM, DM, wl + W_IN_E, DM, (r / 16) * 64, (r % 16) * 64, (r % 16) * 64, tile); }
        else if ((r -= 256) < 1408) { const int n0 = (r % 88) * 64; const int up = n0 >= FFN; const int j0 = up ? n0 - FFN : n0; const int nd = 256 * (j0 / 128) + (up ? 128 : 0) + (j0 % 128);
          transpose_tile(P.in[18] + (size_t)l * DM * 2 * FFN, 2 * FFN, wl + W_IN_E + W_OUT_E, DM, (r / 88) * 64, n0, nd, tile); }
        else if ((r -= 1408) < 704) { transpose_tile(P.in[19] + (size_t)l * FFN * DM, DM, wl + W_IN_E + W_OUT_E + W_GU_E, FFN, (r / 16) * 64, (r % 16) * 64, (r % 16) * 64, tile); }
        else { r -= 704; transpose_tile(P.in[14] + (size_t)(l * 4 + r) * 4096, 64, WPOOL + (size_t)(l * 4 + r) * 4096, 64, 0, 0, 0, tile); }
      } else {
        for (int i = tid; i < 64 * 16; i += NTHREADS) { const int pos = i >> 4, f = i & 15; const float inv = 1.0f / powf(10000.0f, (float)f / 16.0f); const float ang = (float)pos * inv;
          ROPE[i] = cosf(ang); ROPE[1024 + i] = sinf(ang); }
        if (tid < DEPTH) { const int l = tid; float d1 = 0.f, d2 = 0.f;
          for (int i = 0; i < 64; ++i) { d1 += P.in[8][l * 64 + i] * P.in[9][l * 64 + i]; d2 += P.in[10][l * 64 + i] * P.in[11][l * 64 + i]; }
          const float li = 0.8f - 0.6f * expf(-0.3f * (float)l);
          LAMV[l * 2] = expf(d1) - expf(d2) + li; LAMV[l * 2 + 1] = 1.f - li; }
      }
    }
  }
  for (int i = bid * NTHREADS + tid; i < NFUSE * MALL; i += G * NTHREADS) { const f32x4 m1 = {-1.f, -1.f, -1.f, -1.f}; f32x4* sp = (f32x4*)XCH + i;
    asm volatile("global_store_dwordx4 %0, %1, off sc1" :: "v"(sp), "v"(m1) : "memory"); }
  for (int i = bid * NTHREADS + tid; i < 2 * DM; i += G * NTHREADS) ((float*)CNT)[i] = 0.f;
  const bool fuse_ok = (G == 256);
  unsigned* BARC = (unsigned*)(ws + WS_BAR); unsigned nbar = 0;
  if (bid == 0 && tid == 0) __hip_atomic_store(BARC, 0u, __ATOMIC_RELAXED, __HIP_MEMORY_SCOPE_AGENT);
  grid.sync();

  for (int l = 0; l < DEPTH; ++l) {
    const bool last = (l == DEPTH - 1);
    const float* modl = MOD + (size_t)l * 33 * NMOD * DM;
    const bf16_t* wl = WB + (size_t)l * W_LAYER_E;
    if (l == 0) { norm_phase<true>(x_in, ctx_in, XB, P.in[6] + l * DM, modl, 0, 1, ACT, MALL); grid_bar(BARC, (unsigned)G * (++nbar)); }
    else if (!fuse_ok) { norm_phase<false>(nullptr, nullptr, XB, P.in[6] + l * DM, modl, 0, 1, ACT, MALL); grid_bar(BARC, (unsigned)G * (++nbar)); }
    for (int rep = 0; rep < ((DUP & 2) ? 2 : 1); ++rep)
    if constexpr (EN(2)) { pg8::Gemm g{ACT, wl, DM}; pg8::Sched S; S.init(INC / 256, MCTX / 256, last ? 2 : 0, last ? 4 : INC / 256, G, bid);
      pg8::EpiProj E{PROJ, ROPE, ROPE + 1024};
      pg8::gemm_phase<pg8::EpiProj>((LAS unsigned char*)lds, g, S, E); }
    grid_bar(BARC, (unsigned)G * (++nbar));
    for (int rep = 0; rep < ((DUP & 1) ? 2 : 1); ++rep)
    if constexpr (EN(3)) { const float lam = LAMV[l * 2], post = LAMV[l * 2 + 1]; const float* gsub = P.in[12] + l * 128;
      const int nAttL = NB * 4 * 16, nAttC = last ? 0 : NB * 4 * 2, nMix = last ? MLAT / 64 : MALL / 64;
      const int nItems = nAttL + nAttC + nMix;
      for (int it = bid; it < nItems; it += G) {
        if (it < nAttL + nAttC) { int bh, qb, qrow0, lrow0, NT;
          if (it < nAttL) {
            if (G == 256) { const int j = it & 255, k = it >> 8, xcd = j & 7, slot = j >> 3; bh = k * 16 + xcd * 2 + (slot >> 4); qb = slot & 15; } else { bh = it >> 4; qb = it & 15; }
            qrow0 = (bh >> 2) * SEQ + qb * 128; lrow0 = (bh >> 2) * SEQ; NT = 36;
          } else { const int id = it - nAttL; bh = id >> 1; qb = id & 1; qrow0 = MLAT + (bh >> 2) * CTXL + qb * 128; lrow0 = 0; NT = 4; }
          att::attn_item(PROJ, ACT, qrow0, bh & 3, MLAT + (bh >> 2) * CTXL, lrow0, NT, lam, post, gsub, (char*)lds);
        } else { const int tile = it - nAttL - nAttC; int rb, p0, Ls;
          if (tile < MLAT / 64) { rb = tile * 64; p0 = (tile & 31) * 64; Ls = SEQ; } else { rb = tile * 64; p0 = (tile & 3) * 64; Ls = CTXL; }
          for (int rep2 = 0; rep2 < ((DUP & 32) ? 2 : 1); ++rep2)
          mixer_item(PROJ, ACT, rb, p0, Ls, P.in[13] + l * 768, WPOOL + (size_t)l * 4 * 4096, P.in[15] + l * 256, (char*)lds);
        }
      }
    }
    grid_bar(BARC, (unsigned)G * (++nbar));
    if constexpr (EN(4)) { pg8::Gemm g{ACT, wl + W_IN_E, DM}; pg8::Sched S; S.init(DM / 256, last ? 0 : MCTX / 256, 0, DM / 256, G, bid);
      pg8::EpiResNorm E{XB, modl + 2 * DM, fuse_ok, H2, P.in[17] + l * DM, modl, 3, 4, XCH + (size_t)(2 * l) * MALL * 4, (LAS unsigned char*)lds + pg8::STAGE_BYTES, nullptr, NMOD * DM};
      pg8::gemm_phase<pg8::EpiResNorm>((LAS unsigned char*)lds, g, S, E); }
    grid_bar(BARC, (unsigned)G * (++nbar));
    if (!fuse_ok) { norm_phase<false>(nullptr, nullptr, XB, P.in[17] + l * DM, modl, 3, 4, H2, last ? MLAT : MALL); grid_bar(BARC, (unsigned)G * (++nbar)); }
    for (int rep = 0; rep < ((DUP & 2) ? 2 : 1); ++rep)
    if constexpr (EN(6)) { pg8::Gemm g{H2, wl + W_IN_E + W_OUT_E, DM}; pg8::Sched S; S.init(2 * FFN / 256, last ? 0 : MCTX / 256, 0, 2 * FFN / 256, G, bid);
      pg8::EpiSwi E{PROJ};
      pg8::gemm_phase<pg8::EpiSwi>((LAS unsigned char*)lds, g, S, E); }
    grid_bar(BARC, (unsigned)G * (++nbar));
    if constexpr (EN(7)) { pg8::Gemm g{PROJ, wl + W_IN_E + W_OUT_E + W_GU_E, FFN}; pg8::Sched S; S.init(DM / 256, last ? 0 : MCTX / 256, 0, DM / 256, G, bid);
      const int ln = last ? l : l + 1;
      const bool fin = last && fuse_ok;
      pg8::EpiResNorm E{XB, modl + 5 * DM, fuse_ok, ACT, fin ? P.in[20] : P.in[6] + ln * DM, fin ? (const float*)CNT : MOD + (size_t)ln * 33 * NMOD * DM, 0, 1, XCH + (size_t)(2 * l + 1) * MALL * 4, (LAS unsigned char*)lds + pg8::STAGE_BYTES, fin ? P.out : nullptr, fin ? 0 : NMOD * DM};
      pg8::gemm_phase<pg8::EpiResNorm>((LAS unsigned char*)lds, g, S, E); }
    grid_bar(BARC, (unsigned)G * (++nbar));
  }
  if (!fuse_ok) final_norm(XB, P.out, P.in[20]);
}

extern "C" void kernel_launch(void* const* d_in, const int* in_sizes, int n_in, void* d_out, int out_size, void* d_ws, size_t ws_size, hipStream_t stream) {
  static int grid_blocks = 0;
  if (grid_blocks == 0) {
    if (n_in != 21 || out_size != MLAT * DM || ws_size < WS_END) { fprintf(stderr, "kernel_launch: unexpected shapes n_in %d out %d ws %zu (need %zu)\n", n_in, out_size, ws_size, (size_t)WS_END); grid_blocks = -1; return; }
    int dev = 0, cus = 0, per_cu = 0;
    hipGetDevice(&dev); hipDeviceGetAttribute(&cus, hipDeviceAttributeMultiprocessorCount, dev);
    if (hipFuncSetAttribute((const void*)fwd_megakernel, hipFuncAttributeMaxDynamicSharedMemorySize, LDS_BYTES) != hipSuccess) { fprintf(stderr, "kernel_launch: hipFuncSetAttribute failed\n"); grid_blocks = -1; return; }
    hipOccupancyMaxActiveBlocksPerMultiprocessor(&per_cu, (const void*)fwd_megakernel, NTHREADS, LDS_BYTES);
    if (per_cu < 1) { fprintf(stderr, "kernel_launch: occupancy query says %d blocks per CU\n", per_cu); per_cu = 1; }
    grid_blocks = cus * 1;
    (void)hipGetLastError();
  }
  if (grid_blocks < 0) return;
  Params p{};
  for (int i = 0; i < 21; ++i) p.in[i] = (const float*)d_in[i];
  p.out = (float*)d_out; p.ws = (unsigned char*)d_ws;
  void* args[] = {&p};
  hipError_t e = hipLaunchCooperativeKernel((const void*)fwd_megakernel, dim3(grid_blocks), dim3(NTHREADS), args, LDS_BYTES, stream);
  if (e != hipSuccess) fprintf(stderr, "cooperative launch failed: %s (grid %d)\n", hipGetErrorString(e), grid_blocks);
}
```

```cpp
#include <hip/hip_runtime.h>
#include <hip/hip_cooperative_groups.h>
#include <cstdio>
#include <cstdint>
namespace cg = cooperative_groups;

#define LAS __attribute__((address_space(3)))
typedef unsigned short bf16_t;
typedef short bf16x8 __attribute__((ext_vector_type(8)));
typedef short s16x4 __attribute__((ext_vector_type(4)));
typedef float f32x4 __attribute__((ext_vector_type(4)));
typedef float f32x16 __attribute__((ext_vector_type(16)));
typedef unsigned u32x4 __attribute__((ext_vector_type(4)));
typedef unsigned u32x2 __attribute__((ext_vector_type(2)));

constexpr int DM = 1024, NB = 32, SEQ = 2048, DEPTH = 4, CTXL = 256;
constexpr int MLAT = NB * SEQ, MCTX = NB * CTXL, MALL = MLAT + MCTX;
constexpr int INC = 2560, FFN = 2816, NMOD = 6;
constexpr float EPS = 1e-6f;
constexpr int NTHREADS = 512;
constexpr int LDS_BYTES = 152 * 1024;

constexpr size_t WS_XB   = 0;
constexpr size_t WS_ACT  = WS_XB + (size_t)MALL * DM * 2;
constexpr size_t WS_PROJ = WS_ACT + (size_t)MALL * DM * 2;
constexpr size_t WS_W    = WS_PROJ + (size_t)MALL * FFN * 2;
constexpr size_t W_IN_E = (size_t)INC * DM, W_OUT_E = (size_t)DM * DM, W_GU_E = (size_t)2 * FFN * DM, W_DN_E = (size_t)DM * FFN;
constexpr size_t W_LAYER_E = W_IN_E + W_OUT_E + W_GU_E + W_DN_E;
constexpr size_t WS_WPOOL = WS_W + W_LAYER_E * 2 * DEPTH;
constexpr size_t WS_MOD  = WS_WPOOL + (size_t)DEPTH * 4 * 64 * 64 * 2;
constexpr size_t WS_ROPE = WS_MOD + (size_t)DEPTH * 33 * NMOD * DM * 4;
constexpr size_t WS_LAM  = WS_ROPE + 2 * 64 * 16 * 4;
constexpr size_t WS_BAR  = WS_LAM + 256;
constexpr size_t WS_H2   = WS_BAR + 256;
constexpr int    NFUSE   = 2 * DEPTH;
constexpr size_t WS_XCH  = WS_H2 + (size_t)MALL * DM * 2;
constexpr size_t WS_CNT  = WS_XCH + (size_t)NFUSE * MALL * 4 * 4;
constexpr size_t WS_END  = WS_CNT + (size_t)NFUSE * (MALL / 256) * 256;

#ifndef ONLY
#define ONLY -1
#endif
#define EN(n) (ONLY < 0 || ONLY == (n))
#ifndef DUP
#define DUP 0
#endif
struct Params { const float* in[21]; float* out; unsigned char* ws; };

__device__ __forceinline__ int opaque_tid() { int t = threadIdx.x; asm volatile("" : "+v"(t)); return t; }
__device__ __forceinline__ float bperm_xor(float v, int m, int lane) { return __builtin_bit_cast(float, __builtin_amdgcn_ds_bpermute((lane ^ m) << 2, __builtin_bit_cast(int, v))); }
__device__ __forceinline__ unsigned cvt_pk_bf16(float lo, float hi) { unsigned r; asm volatile("v_cvt_pk_bf16_f32 %0, %1, %2" : "=v"(r) : "v"(lo), "v"(hi)); return r; }

namespace pg8 {
constexpr int BM = 256, BK = 64, HALF = 128, HTB = HALF * BK * 2, STAGE_BYTES = 8 * HTB;
__device__ __forceinline__ int lds_byte(int r, int c) { const int st = (r >> 4) * 2 + (c >> 5), rr = r & 15, cc = c & 31, ob = rr * 64 + cc * 2; return st * 1024 + (ob ^ (((ob >> 9) & 1) << 5)); }
__device__ __forceinline__ void stage_rc(int b, int& R, int& C) { const int st = b / 1024, sb = b % 1024, swz = sb ^ (((sb >> 9) & 1) << 5); R = (st >> 1) * 16 + swz / 64; C = (st & 1) * 32 + (swz % 64) / 2; }
__device__ __forceinline__ int perm32(int rho) { const int n = rho >> 4, i = rho & 15; return 8 * (i >> 2) + 4 * n + (i & 3); }
struct Unit { int pm, pn; };
struct Gemm { const bf16_t* A; const bf16_t* Bt; int K; };

struct Sched {
    int nN, nLat, nTot, G, c, cpn0, cnN;
    __device__ void init(int nN_, int nCtxRows, int cpn0_, int cnN_, int G_, int c_) { nN = nN_; nLat = 256 * nN_; cpn0 = cpn0_; cnN = cnN_; nTot = nLat + nCtxRows * cnN_; G = G_; c = c_; }
    __device__ __forceinline__ bool next(int i, Unit& u) const {
        const int L = i * G + c; if (L >= nTot) return false;
        if (L < nLat) {
            const int q = nLat >> 3; const int wgid = (L & 7) * q + (L >> 3);
            const int nig = 8 * nN, gid = wgid / nig, rem = wgid % nig;
            u.pm = gid * 8 + (rem & 7); u.pn = rem >> 3;
        } else { const int Lc = L - nLat; u.pm = 256 + Lc / cnN; u.pn = cpn0 + Lc % cnN; }
        return true;
    }
};

template <class Epi>
__device__ __forceinline__ void gemm_phase(LAS unsigned char* lds, const Gemm g, const Sched& S, const Epi& E) {
    const int tid = opaque_tid(), wid = __builtin_amdgcn_readfirstlane(tid >> 6), lane = tid & 63, wr = wid >> 2, wc = wid & 3, fr = lane & 15, fq = lane >> 4;
    const int K = g.K, nt = K / BK;
    unsigned voffA[2], voffB[2];
#pragma unroll
    for (int i = 0; i < 2; ++i) { int R, C; stage_rc(tid * 16 + i * 8192, R, C); const int Rb = Epi::PERM ? ((R & ~31) + perm32(R & 31)) : R;
        voffA[i] = (unsigned)(R * K + C) * 2u; voffB[i] = (unsigned)(Rb * K + C) * 2u; }
    const size_t kstep = (size_t)(BK * 2);
    const size_t hstep = (size_t)HALF * K * 2;
    const size_t tstep = 2 * hstep;
    const unsigned ldsw = (unsigned)wid * 1024u;
    const int aoff = lds_byte(wr * 64 + fr, fq * 8), boff = lds_byte(wc * 32 + fr, fq * 8);
#define PG8_SA(b, h) (((b) * 2 + (h)) * HTB)
#define PG8_SB(b, h) ((4 + (b) * 2 + (h)) * HTB)
#define PG8_STAGE(bufoff, gbase, voff) do { _Pragma("unroll") for (int _i = 0; _i < 2; ++_i) \
        __builtin_amdgcn_global_load_lds((const unsigned*)((const char*)(gbase) + (voff)[_i]), (LAS unsigned*)(lds + (bufoff) + ldsw + _i * 8192), 16, 0, 0); } while (0)
#define PG8_LDA(dst, b, h) do { _Pragma("unroll") for (int m = 0; m < 4; ++m) _Pragma("unroll") for (int k = 0; k < 2; ++k) dst[m][k] = *(const LAS bf16x8*)(lds + PG8_SA(b, h) + aoff + m * 2048 + k * 1024); } while (0)
#define PG8_LDB(dst, b, h) do { _Pragma("unroll") for (int n = 0; n < 2; ++n) _Pragma("unroll") for (int k = 0; k < 2; ++k) dst[n][k] = *(const LAS bf16x8*)(lds + PG8_SB(b, h) + boff + n * 2048 + k * 1024); } while (0)
#define PG8_MMA(ai, bj, At, Bt) do { __builtin_amdgcn_s_setprio(1); _Pragma("unroll") for (int m = 0; m < 4; ++m) _Pragma("unroll") for (int n = 0; n < 2; ++n) _Pragma("unroll") for (int k = 0; k < 2; ++k) \
        acc[ai][bj][m][n] = __builtin_amdgcn_mfma_f32_16x16x32_bf16(Bt[n][k], At[m][k], acc[ai][bj][m][n], 0, 0, 0); __builtin_amdgcn_s_setprio(0); } while (0)
#define PG8_WAIT_V(n) asm volatile("s_waitcnt vmcnt(" #n ")" ::: "memory")
#define PG8_WAIT_L(n) asm volatile("s_waitcnt lgkmcnt(" #n ")" ::: "memory")
#define PG8_BAR __builtin_amdgcn_s_barrier()
#define PG8_SCHED __builtin_amdgcn_sched_barrier(0)
    Unit cur, nxt; int ui = 0;
    if (!S.next(0, cur)) return;
    f32x4 acc[2][2][4][2];
#pragma unroll
    for (int a = 0; a < 2; ++a)
#pragma unroll
        for (int b = 0; b < 2; ++b)
#pragma unroll
            for (int m = 0; m < 4; ++m)
#pragma unroll
                for (int n = 0; n < 2; ++n) acc[a][b][m][n] = (f32x4){0.f, 0.f, 0.f, 0.f};
    bf16x8 At[4][2], B0[2][2], B1[2][2];
    const char* cA = (const char*)g.A + (size_t)cur.pm * tstep; const char* cB = (const char*)g.Bt + (size_t)cur.pn * tstep;
    PG8_STAGE(PG8_SB(0, 0), cB, voffB); PG8_STAGE(PG8_SB(0, 1), cB + hstep, voffB); PG8_STAGE(PG8_SA(0, 0), cA, voffA); PG8_STAGE(PG8_SA(0, 1), cA + hstep, voffA);
    if (wr == 1) PG8_BAR;
    PG8_WAIT_V(2); PG8_BAR;
    PG8_STAGE(PG8_SB(1, 0), cB + kstep, voffB); PG8_STAGE(PG8_SA(1, 0), cA + kstep, voffA); PG8_STAGE(PG8_SB(1, 1), cB + hstep + kstep, voffB);
    PG8_WAIT_V(6); PG8_BAR;
    for (;;) {
        const bool has_next = S.next(ui + 1, nxt);
        const char* nA = has_next ? (const char*)g.A + (size_t)nxt.pm * tstep : cA; const char* nB = has_next ? (const char*)g.Bt + (size_t)nxt.pn * tstep : cB;
        for (int t = 0; t < nt; t += 2) {
            const bool last = (t == nt - 2);
            const char* a1 = cA + (size_t)(t + 1) * kstep;
            const char* a2 = last ? nA : cA + (size_t)(t + 2) * kstep; const char* b2 = last ? nB : cB + (size_t)(t + 2) * kstep;
            const char* a3 = a2 + kstep; const char* b3 = b2 + kstep;
            PG8_LDB(B0, 0, 0); PG8_LDB(B1, 0, 1); PG8_SCHED; PG8_LDA(At, 0, 0); PG8_STAGE(PG8_SA(1, 1), a1 + hstep, voffA);
            PG8_WAIT_V(8); PG8_WAIT_L(0); PG8_BAR; PG8_MMA(0, 0, At, B0); PG8_MMA(0, 1, At, B1); PG8_BAR; PG8_SCHED;
            PG8_LDA(At, 0, 1); PG8_STAGE(PG8_SB(0, 0), b2, voffB); PG8_STAGE(PG8_SB(0, 1), b2 + hstep, voffB); PG8_STAGE(PG8_SA(0, 0), a2, voffA);
            PG8_WAIT_V(8); PG8_WAIT_L(0); PG8_BAR; PG8_MMA(1, 0, At, B0); PG8_MMA(1, 1, At, B1); PG8_BAR; PG8_SCHED;
            PG8_LDB(B0, 1, 0); PG8_LDB(B1, 1, 1); PG8_SCHED; PG8_LDA(At, 1, 0); PG8_STAGE(PG8_SA(0, 1), a2 + hstep, voffA);
            PG8_WAIT_V(8); PG8_WAIT_L(0); PG8_BAR; PG8_MMA(0, 0, At, B0); PG8_MMA(0, 1, At, B1); PG8_BAR; PG8_SCHED;
            PG8_LDA(At, 1, 1); PG8_STAGE(PG8_SB(1, 0), b3, voffB); PG8_STAGE(PG8_SB(1, 1), b3 + hstep, voffB); PG8_STAGE(PG8_SA(1, 0), a3, voffA);
            PG8_WAIT_V(8); PG8_WAIT_L(0); PG8_BAR; PG8_MMA(1, 0, At, B0); PG8_MMA(1, 1, At, B1); PG8_BAR; PG8_SCHED;
        }
        if (wr == 0) PG8_BAR;
        E(acc, cur, wr, wc, fr, fq);
        if (!has_next) break;
#pragma unroll
        for (int a = 0; a < 2; ++a)
#pragma unroll
            for (int b = 0; b < 2; ++b)
#pragma unroll
                for (int m = 0; m < 4; ++m)
#pragma unroll
                    for (int n = 0; n < 2; ++n) acc[a][b][m][n] = (f32x4){0.f, 0.f, 0.f, 0.f};
        cur = nxt; cA = nA; cB = nB; ++ui;
        if (wr == 1) PG8_BAR;
    }
    PG8_WAIT_V(0);
    PG8_BAR;
#undef PG8_SA
#undef PG8_SB
#undef PG8_STAGE
#undef PG8_LDA
#undef PG8_LDB
#undef PG8_MMA
#undef PG8_WAIT_V
#undef PG8_WAIT_L
#undef PG8_BAR
#undef PG8_SCHED
}

struct EpiProj {
    static constexpr bool PERM = true;
    bf16_t* O; const float* cosT; const float* sinT;
    __device__ __forceinline__ void operator()(const f32x4 (&acc)[2][2][4][2], const Unit& u, int wr, int wc, int fr, int fq) const {
        const int row0 = u.pm * BM + wr * 64 + fr, col0 = u.pn * BM + wc * 32 + 8 * fq;
        const bool rope = (u.pm < 256) && (u.pn < 4);
        const float sgn = (fq & 2) ? 1.f : -1.f; const int lane_ = (fq << 4) | fr;
#pragma unroll
        for (int ai = 0; ai < 2; ++ai)
#pragma unroll
            for (int m = 0; m < 4; ++m) {
                const int r = row0 + ai * HALF + m * 16;
                f32x4 c0 = {1.f, 1.f, 1.f, 1.f}, c1 = c0, s0 = {0.f, 0.f, 0.f, 0.f}, s1 = s0;
                if (rope) { const int p = r & (SEQ - 1); const int pos = (wc & 1) ? (p & 63) : (p >> 6); const int f0 = 8 * (fq & 1);
                    c0 = *(const f32x4*)(cosT + pos * 16 + f0); c1 = *(const f32x4*)(cosT + pos * 16 + f0 + 4);
                    s0 = *(const f32x4*)(sinT + pos * 16 + f0); s1 = *(const f32x4*)(sinT + pos * 16 + f0 + 4); }
                if (u.pn == 7 || u.pn == 8) {
                    const f32x4 u0 = acc[ai][0][m][0] * acc[ai][1][m][0], u1 = acc[ai][0][m][1] * acc[ai][1][m][1];
                    u32x4 w; w.x = cvt_pk_bf16(u0[0], u0[1]); w.y = cvt_pk_bf16(u0[2], u0[3]); w.z = cvt_pk_bf16(u1[0], u1[1]); w.w = cvt_pk_bf16(u1[2], u1[3]);
                    *(u32x4*)(O + (size_t)r * INC + 1792 + (u.pn - 7) * HALF + wc * 32 + 8 * fq) = w; continue; }
                bf16_t* rowp = O + (size_t)r * INC + col0;
#pragma unroll
                for (int bj = 0; bj < 2; ++bj) { f32x4 v0 = acc[ai][bj][m][0], v1 = acc[ai][bj][m][1];
                    if (rope) {
#pragma unroll
                        for (int j = 0; j < 4; ++j) { const float p0 = bperm_xor(v0[j], 32, lane_), p1 = bperm_xor(v1[j], 32, lane_);
                            v0[j] = v0[j] * c0[j] + sgn * p0 * s0[j]; v1[j] = v1[j] * c1[j] + sgn * p1 * s1[j]; } }
                    u32x4 w; w.x = cvt_pk_bf16(v0[0], v0[1]); w.y = cvt_pk_bf16(v0[2], v0[3]); w.z = cvt_pk_bf16(v1[0], v1[1]); w.w = cvt_pk_bf16(v1[2], v1[3]);
                    *(u32x4*)(rowp + bj * HALF) = w; } }
    }
};
struct EpiResB {
    static constexpr bool PERM = true;
    bf16_t* X; const float* gate;
    __device__ __forceinline__ void operator()(const f32x4 (&acc)[2][2][4][2], const Unit& u, int wr, int wc, int fr, int fq) const {
        const int b = (u.pm < 256) ? (u.pm >> 3) : 32;
        const int row0 = u.pm * BM + wr * 64 + fr, col0 = u.pn * BM + wc * 32 + 8 * fq;
        f32x4 gv[2][2];
#pragma unroll
        for (int bj = 0; bj < 2; ++bj)
#pragma unroll
            for (int n = 0; n < 2; ++n) gv[bj][n] = *(const f32x4*)(gate + (size_t)b * (NMOD * DM) + col0 + bj * HALF + n * 4);
#pragma unroll
        for (int ai = 0; ai < 2; ++ai) {
            u32x4 xv[4][2];
#pragma unroll
            for (int m = 0; m < 4; ++m)
#pragma unroll
                for (int bj = 0; bj < 2; ++bj) xv[m][bj] = *(const u32x4*)(X + (size_t)(row0 + ai * HALF + m * 16) * DM + col0 + bj * HALF);
#pragma unroll
            for (int m = 0; m < 4; ++m)
#pragma unroll
                for (int bj = 0; bj < 2; ++bj) { const u32x4 xw = xv[m][bj]; const f32x4 a0 = acc[ai][bj][m][0] * gv[bj][0], a1 = acc[ai][bj][m][1] * gv[bj][1];
                    u32x4 w;
                    w.x = cvt_pk_bf16(__uint_as_float(xw.x << 16) + a0[0], __uint_as_float(xw.x & 0xffff0000u) + a0[1]);
                    w.y = cvt_pk_bf16(__uint_as_float(xw.y << 16) + a0[2], __uint_as_float(xw.y & 0xffff0000u) + a0[3]);
                    w.z = cvt_pk_bf16(__uint_as_float(xw.z << 16) + a1[0], __uint_as_float(xw.z & 0xffff0000u) + a1[1]);
                    w.w = cvt_pk_bf16(__uint_as_float(xw.w << 16) + a1[2], __uint_as_float(xw.w & 0xffff0000u) + a1[3]);
                    *(u32x4*)(X + (size_t)(row0 + ai * HALF + m * 16) * DM + col0 + bj * HALF) = w; } }
    }
};
struct EpiResNorm {
    static constexpr bool PERM = true;
    bf16_t* X; const float* gate; bool fuse;
    bf16_t* H; const float* gw; const float* modn; int shi, sci;
    float* xch; LAS unsigned char* tab;
    float* F; int mstride;
    __device__ __forceinline__ void operator()(f32x4 (&acc)[2][2][4][2], const Unit& u, int wr, int wc, int fr, int fq) const {
        const int b = (u.pm < 256) ? (u.pm >> 3) : 32;
        const int row0 = u.pm * BM + wr * 64 + fr, col0 = u.pn * BM + wc * 32 + 8 * fq;
        { f32x4 gv[2][2];
#pragma unroll
          for (int bj = 0; bj < 2; ++bj)
#pragma unroll
            for (int n = 0; n < 2; ++n) gv[bj][n] = *(const f32x4*)(gate + (size_t)b * (NMOD * DM) + col0 + bj * HALF + n * 4);
#pragma unroll
          for (int ai = 0; ai < 2; ++ai) {
            u32x4 xv[4][2];
#pragma unroll
            for (int m = 0; m < 4; ++m)
#pragma unroll
                for (int bj = 0; bj < 2; ++bj) xv[m][bj] = *(const u32x4*)(X + (size_t)(row0 + ai * HALF + m * 16) * DM + col0 + bj * HALF);
#pragma unroll
            for (int m = 0; m < 4; ++m)
#pragma unroll
                for (int bj = 0; bj < 2; ++bj) { const u32x4 xw = xv[m][bj]; f32x4 a0 = acc[ai][bj][m][0] * gv[bj][0], a1 = acc[ai][bj][m][1] * gv[bj][1];
                    a0[0] += __uint_as_float(xw.x << 16); a0[1] += __uint_as_float(xw.x & 0xffff0000u); a0[2] += __uint_as_float(xw.y << 16); a0[3] += __uint_as_float(xw.y & 0xffff0000u);
                    a1[0] += __uint_as_float(xw.z << 16); a1[1] += __uint_as_float(xw.z & 0xffff0000u); a1[2] += __uint_as_float(xw.w << 16); a1[3] += __uint_as_float(xw.w & 0xffff0000u);
                    acc[ai][bj][m][0] = a0; acc[ai][bj][m][1] = a1; } } }
        const int tid = threadIdx.x;
        LAS float* Pt = (LAS float*)tab; LAS float* St = (LAS float*)(tab + 4096);
        if (fuse) {
#pragma unroll
            for (int ai = 0; ai < 2; ++ai)
#pragma unroll
                for (int m = 0; m < 4; ++m) { float q = 0.f;
#pragma unroll
                    for (int bj = 0; bj < 2; ++bj)
#pragma unroll
                        for (int n = 0; n < 2; ++n) { const f32x4 x = acc[ai][bj][m][n]; q += (x[0] * x[0] + x[1] * x[1]) + (x[2] * x[2] + x[3] * x[3]); }
                    q += bperm_xor(q, 16, (fq << 4) | fr); q += bperm_xor(q, 32, (fq << 4) | fr);
                    if (fq == 0) Pt[(ai * HALF + wr * 64 + m * 16 + fr) * 4 + wc] = q; }
            asm volatile("s_waitcnt lgkmcnt(0)" ::: "memory"); __builtin_amdgcn_s_barrier(); asm volatile("" ::: "memory");
            if (tid < 256) { const float t = (Pt[tid * 4 + 0] + Pt[tid * 4 + 1]) + (Pt[tid * 4 + 2] + Pt[tid * 4 + 3]);
                __hip_atomic_store(xch + ((size_t)u.pm * BM + tid) * 4 + u.pn, t, __ATOMIC_RELAXED, __HIP_MEMORY_SCOPE_AGENT); }
        }
#pragma unroll
        for (int ai = 0; ai < 2; ++ai)
#pragma unroll
            for (int m = 0; m < 4; ++m)
#pragma unroll
                for (int bj = 0; bj < 2; ++bj) { const f32x4 a0 = acc[ai][bj][m][0], a1 = acc[ai][bj][m][1];
                    u32x4 w; w.x = cvt_pk_bf16(a0[0], a0[1]); w.y = cvt_pk_bf16(a0[2], a0[3]); w.z = cvt_pk_bf16(a1[0], a1[1]); w.w = cvt_pk_bf16(a1[2], a1[3]);
                    *(u32x4*)(X + (size_t)(row0 + ai * HALF + m * 16) * DM + col0 + bj * HALF) = w; }
        if (!fuse) return;
        if (tid < 256) { const float* sl = xch + ((size_t)u.pm * BM + tid) * 4; f32x4 v;
            for (int spin = 0; spin < (1 << 22); ++spin) {
                asm volatile("global_load_dwordx4 %0, %1, off sc1\n\ts_waitcnt vmcnt(0)" : "=&v"(v) : "v"(sl) : "memory");
                const bool ok = (v[0] >= 0.f) && (v[1] >= 0.f) && (v[2] >= 0.f) && (v[3] >= 0.f);
                if (__all(ok)) break;
                __builtin_amdgcn_s_sleep(1); }
            St[tid] = rsqrtf(((v[0] + v[1]) + (v[2] + v[3])) * (1.f / DM) + EPS); }
        asm volatile("s_waitcnt vmcnt(0) lgkmcnt(0)" ::: "memory"); __builtin_amdgcn_s_barrier(); asm volatile("" ::: "memory");
        const float* mb = modn + (size_t)b * mstride;
#pragma unroll
        for (int bj = 0; bj < 2; ++bj) { f32x4 gg[2], sc[2], sh[2];
#pragma unroll
            for (int n = 0; n < 2; ++n) { const int c = col0 + bj * HALF + n * 4; gg[n] = *(const f32x4*)(gw + c); sc[n] = *(const f32x4*)(mb + sci * DM + c) + 1.f; sh[n] = *(const f32x4*)(mb + shi * DM + c); gg[n] = gg[n] * sc[n]; }
#pragma unroll
            for (int ai = 0; ai < 2; ++ai)
#pragma unroll
                for (int m = 0; m < 4; ++m) { const float rs = St[ai * HALF + wr * 64 + m * 16 + fr];
                    const f32x4 y0 = (acc[ai][bj][m][0] * rs) * gg[0] + sh[0], y1 = (acc[ai][bj][m][1] * rs) * gg[1] + sh[1];
                    if (F) { float* op = F + (size_t)(row0 + ai * HALF + m * 16) * DM + col0 + bj * HALF; *(f32x4*)op = y0; *(f32x4*)(op + 4) = y1; }
                    else { u32x4 w; w.x = cvt_pk_bf16(y0[0], y0[1]); w.y = cvt_pk_bf16(y0[2], y0[3]); w.z = cvt_pk_bf16(y1[0], y1[1]); w.w = cvt_pk_bf16(y1[2], y1[3]);
                        *(u32x4*)(H + (size_t)(row0 + ai * HALF + m * 16) * DM + col0 + bj * HALF) = w; } } }
    }
};
struct EpiSwi {
    static constexpr bool PERM = true;
    bf16_t* O;
    __device__ __forceinline__ void operator()(const f32x4 (&acc)[2][2][4][2], const Unit& u, int wr, int wc, int fr, int fq) const {
        const int row0 = u.pm * BM + wr * 64 + fr, col0 = u.pn * HALF + wc * 32 + 8 * fq;
#pragma unroll
        for (int ai = 0; ai < 2; ++ai)
#pragma unroll
            for (int m = 0; m < 4; ++m) { float h[8];
#pragma unroll
                for (int n = 0; n < 2; ++n)
#pragma unroll
                    for (int j = 0; j < 4; ++j) { const float gt = acc[ai][0][m][n][j], up = acc[ai][1][m][n][j];
                        h[n * 4 + j] = gt * __builtin_amdgcn_rcpf(1.f + __builtin_amdgcn_exp2f(-1.4426950408889634f * gt)) * up; }
                u32x4 w; w.x = cvt_pk_bf16(h[0], h[1]); w.y = cvt_pk_bf16(h[2], h[3]); w.z = cvt_pk_bf16(h[4], h[5]); w.w = cvt_pk_bf16(h[6], h[7]);
                *(u32x4*)(O + (size_t)(row0 + ai * HALF + m * 16) * FFN + col0) = w; }
    }
};
}

namespace att {
constexpr int KVBLK = 64;
constexpr float SCALE = 0.125f, THR = 8.f;
constexpr int SHM_V = KVBLK * 128 * 2, SHM_K = KVBLK * 128 * 2;
constexpr int OX_STRIDE = 144;
constexpr int OX_BYTES = 128 * OX_STRIDE * 4;
constexpr int WSCR_OFF = 2 * OX_BYTES;
#define KSWZ(row, colB) ((row) * 256 + ((colB) ^ (((row) & 15) << 4)))
#define SBAR() __builtin_amdgcn_sched_barrier(0)
__device__ __forceinline__ int crow(int r, int hi) { return (r & 3) + 8 * (r >> 2) + 4 * hi; }

__device__ __forceinline__ void partialSM(f32x16& p0, f32x16& p1, float& m_reg, float& mn, float& alpha) {
  constexpr float C = SCALE * 1.4426950408889634f;
  float pmax = p0[0];
#pragma unroll
  for (int r = 1; r < 16; ++r) pmax = fmaxf(pmax, p0[r]);
#pragma unroll
  for (int r = 0; r < 16; ++r) pmax = fmaxf(pmax, p1[r]);
  { auto rr = __builtin_amdgcn_permlane32_swap(__float_as_uint(pmax), __float_as_uint(pmax), false, false);
    pmax = fmaxf(__uint_as_float(rr[0]), __uint_as_float(rr[1])); }
  if (__builtin_expect(__all(pmax - m_reg <= THR / SCALE), 1)) { mn = m_reg; alpha = 1.f; }
  else { mn = fmaxf(m_reg, pmax); alpha = __builtin_amdgcn_exp2f((m_reg - mn) * C); m_reg = mn; }
  float mnC = -mn * C;
#pragma unroll
  for (int r = 0; r < 16; ++r) p0[r] = fmaf(p0[r], C, mnC);
#pragma unroll
  for (int r = 0; r < 16; ++r) p1[r] = fmaf(p1[r], C, mnC);
#pragma unroll
  for (int r = 0; r < 16; ++r) p0[r] = __builtin_amdgcn_exp2f(p0[r]);
}
__device__ __forceinline__ void finishSM(f32x16& p0, f32x16& p1, float alpha, float& l_reg, bf16x8& pa0, bf16x8& pa1, bf16x8& pa2, bf16x8& pa3) {
#pragma unroll
  for (int r = 0; r < 16; ++r) p1[r] = __builtin_amdgcn_exp2f(p1[r]);
  float ps = 0;
#pragma unroll
  for (int r = 0; r < 16; ++r) ps += p0[r];
#pragma unroll
  for (int r = 0; r < 16; ++r) ps += p1[r];
  { auto rr = __builtin_amdgcn_permlane32_swap(__float_as_uint(ps), __float_as_uint(ps), false, false);
    ps = __uint_as_float(rr[0]) + __uint_as_float(rr[1]); }
  l_reg = l_reg * alpha + ps;
#define PKB(P, BASE, OUT) do { u32x4 w = {cvt_pk_bf16(P[BASE + 0], P[BASE + 1]), cvt_pk_bf16(P[BASE + 2], P[BASE + 3]), cvt_pk_bf16(P[BASE + 4], P[BASE + 5]), cvt_pk_bf16(P[BASE + 6], P[BASE + 7])}; \
    OUT = *reinterpret_cast<bf16x8*>(&w); } while (0)
  PKB(p0, 0, pa0); PKB(p0, 8, pa1); PKB(p1, 0, pa2); PKB(p1, 8, pa3);
#undef PKB
}
__device__ __forceinline__ void qk_fin(f32x16& x0, f32x16& x1, const char* Ks, const bf16x8* qr, int r32, int hi, int cmapB,
                                       f32x16& p0, f32x16& p1, float alpha, float& l_reg, bf16x8& pa0, bf16x8& pa1, bf16x8& pa2, bf16x8& pa3) {
  bf16x8 kf[8];
#pragma unroll
  for (int d0 = 0; d0 < 4; ++d0) { const int cb = cmapB + (d0 * 16 + hi * 8) * 2;
    kf[2 * d0] = *reinterpret_cast<const bf16x8*>(Ks + KSWZ(r32, cb)); kf[2 * d0 + 1] = *reinterpret_cast<const bf16x8*>(Ks + KSWZ(32 + r32, cb)); }
  SBAR();
#pragma unroll
  for (int r = 0; r < 16; ++r) p1[r] = __builtin_amdgcn_exp2f(p1[r]);
  SBAR();
  x0 = f32x16{}; x1 = f32x16{};
#pragma unroll
  for (int d0 = 0; d0 < 4; ++d0) { x0 = __builtin_amdgcn_mfma_f32_32x32x16_bf16(kf[2 * d0], qr[d0], x0, 0, 0, 0);
    x1 = __builtin_amdgcn_mfma_f32_32x32x16_bf16(kf[2 * d0 + 1], qr[d0], x1, 0, 0, 0); }
  float ps = 0;
#pragma unroll
  for (int r = 0; r < 16; ++r) ps += p0[r];
#pragma unroll
  for (int r = 0; r < 16; ++r) ps += p1[r];
  { auto rr = __builtin_amdgcn_permlane32_swap(__float_as_uint(ps), __float_as_uint(ps), false, false);
    ps = __uint_as_float(rr[0]) + __uint_as_float(rr[1]); }
  l_reg = l_reg * alpha + ps;
#define PKB(P, BASE, OUT) do { u32x4 w = {cvt_pk_bf16(P[BASE + 0], P[BASE + 1]), cvt_pk_bf16(P[BASE + 2], P[BASE + 3]), cvt_pk_bf16(P[BASE + 4], P[BASE + 5]), cvt_pk_bf16(P[BASE + 6], P[BASE + 7])}; \
    OUT = *reinterpret_cast<bf16x8*>(&w); } while (0)
  PKB(p0, 0, pa0); PKB(p0, 8, pa1); PKB(p1, 0, pa2); PKB(p1, 8, pa3);
#undef PKB
}
__device__ __forceinline__ void qkt(f32x16& p0, f32x16& p1, const char* Ks, const bf16x8* qr, int r32, int hi, int cmapB) {
  p0 = f32x16{}; p1 = f32x16{};
#pragma unroll
  for (int d0 = 0; d0 < 4; ++d0) { int cb = cmapB + (d0 * 16 + hi * 8) * 2;
    bf16x8 b0 = *reinterpret_cast<const bf16x8*>(Ks + KSWZ(r32, cb));
    bf16x8 b1 = *reinterpret_cast<const bf16x8*>(Ks + KSWZ(32 + r32, cb));
    p0 = __builtin_amdgcn_mfma_f32_32x32x16_bf16(b0, qr[d0], p0, 0, 0, 0);
    p1 = __builtin_amdgcn_mfma_f32_32x32x16_bf16(b1, qr[d0], p1, 0, 0, 0); }
}
__device__ __forceinline__ int v_st(int k, int c) { const int kk = k;     return ((kk >> 3) * 4 + (c >> 5)) * 512 + ((kk & 7) * 32 + (c & 31)) * 2; }
__device__ __forceinline__ int v_rd_base(int lane) { return ((lane & 3) << 3) | (((lane >> 2) & 3) << 6) | (((lane >> 4) & 1) << 5) | (((lane >> 5) & 1) << 8); }
constexpr int v_rd_off(int d0, int ks, int half) { return d0 * 512 + ks * 4096 + half * 2048; }
template <int OFF> __device__ __forceinline__ s16x4 tr_read(int vb) {
  s16x4 r; asm volatile("ds_read_b64_tr_b16 %0, %1 offset:%2" : "=&v"(r) : "v"(vb), "i"(OFF) : "memory"); return r;
}
template <int D0> __device__ __forceinline__ void pv_one(f32x16& od, int vb, bf16x8 pa0, bf16x8 pa1, bf16x8 pa2, bf16x8 pa3) {
  const s16x4 l0 = tr_read<v_rd_off(D0, 0, 0)>(vb), h0 = tr_read<v_rd_off(D0, 0, 1)>(vb), l1 = tr_read<v_rd_off(D0, 1, 0)>(vb), h1 = tr_read<v_rd_off(D0, 1, 1)>(vb);
  const s16x4 l2 = tr_read<v_rd_off(D0, 2, 0)>(vb), h2 = tr_read<v_rd_off(D0, 2, 1)>(vb), l3 = tr_read<v_rd_off(D0, 3, 0)>(vb), h3 = tr_read<v_rd_off(D0, 3, 1)>(vb);
  asm volatile("s_waitcnt lgkmcnt(0)" ::: "memory"); SBAR();
#define PK(L, H) (bf16x8){L[0], L[1], L[2], L[3], H[0], H[1], H[2], H[3]}
  od = __builtin_amdgcn_mfma_f32_32x32x16_bf16(PK(l0, h0), pa0, od, 0, 0, 0);
  od = __builtin_amdgcn_mfma_f32_32x32x16_bf16(PK(l1, h1), pa1, od, 0, 0, 0);
  od = __builtin_amdgcn_mfma_f32_32x32x16_bf16(PK(l2, h2), pa2, od, 0, 0, 0);
  od = __builtin_amdgcn_mfma_f32_32x32x16_bf16(PK(l3, h3), pa3, od, 0, 0, 0);
#undef PK
}
__device__ __forceinline__ void pv_d0(f32x16* o, int vb, bf16x8 pa0, bf16x8 pa1, bf16x8 pa2, bf16x8 pa3) {
  pv_one<0>(o[0], vb, pa0, pa1, pa2, pa3); pv_one<1>(o[1], vb, pa0, pa1, pa2, pa3); pv_one<2>(o[2], vb, pa0, pa1, pa2, pa3); pv_one<3>(o[3], vb, pa0, pa1, pa2, pa3);
}

__device__ __forceinline__ void pv_sm(f32x16* o, int vb, bf16x8 pa0, bf16x8 pa1, bf16x8 pa2, bf16x8 pa3, f32x16& p0, f32x16& p1, float& m_reg, float& mn, float& alpha) {
  constexpr float C = SCALE * 1.4426950408889634f;
  pv_one<0>(o[0], vb, pa0, pa1, pa2, pa3);
  float mx0 = p0[0];
#pragma unroll
  for (int r = 1; r < 16; ++r) mx0 = fmaxf(mx0, p0[r]);
  pv_one<1>(o[1], vb, pa0, pa1, pa2, pa3);
  float pmax = mx0;
#pragma unroll
  for (int r = 0; r < 16; ++r) pmax = fmaxf(pmax, p1[r]);
  { auto rr = __builtin_amdgcn_permlane32_swap(__float_as_uint(pmax), __float_as_uint(pmax), false, false);
    pmax = fmaxf(__uint_as_float(rr[0]), __uint_as_float(rr[1])); }
  if (__builtin_expect(__all(pmax - m_reg <= THR / SCALE), 1)) { mn = m_reg; alpha = 1.f; }
  else { mn = fmaxf(m_reg, pmax); alpha = __builtin_amdgcn_exp2f((m_reg - mn) * C); m_reg = mn; }
  const float mnC = -mn * C;
  pv_one<2>(o[2], vb, pa0, pa1, pa2, pa3);
#pragma unroll
  for (int r = 0; r < 16; ++r) p0[r] = fmaf(p0[r], C, mnC);
#pragma unroll
  for (int r = 0; r < 16; ++r) p1[r] = fmaf(p1[r], C, mnC);
#pragma unroll
  for (int r = 0; r < 8; ++r) p0[r] = __builtin_amdgcn_exp2f(p0[r]);
  pv_one<3>(o[3], vb, pa0, pa1, pa2, pa3);
#pragma unroll
  for (int r = 8; r < 16; ++r) p0[r] = __builtin_amdgcn_exp2f(p0[r]);
}

__device__ __forceinline__ void attn_item(const bf16_t* __restrict__ proj, bf16_t* __restrict__ mix, int qrow0, int h, int crow0, int lrow0, int NT,
                                       float lam, float postscale, const float* __restrict__ gsub, char* lds) {
  const int tid = opaque_tid(), wid = tid >> 6, lane = tid & 63, r32 = lane & 31, hi = lane >> 5;
  const int cmap = wid >> 2, wq = wid & 3, cmapB = cmap * 128;
  char* V_lds = lds; char* K_lds = lds + 2 * SHM_V;
  float* wsx = (float*)(lds + WSCR_OFF) + wid * 64; float* li_l = wsx; float* al_l = wsx + 32;
  float m_reg = -1e30f, l_reg = 0; f32x16 o[4] = {}; bf16x8 qr[4];
  const bf16_t* Qw = proj + (size_t)(qrow0 + wq * 32 + r32) * INC + h * 128 + cmap * 64 + hi * 8;
#pragma unroll
  for (int d0 = 0; d0 < 4; ++d0) qr[d0] = *reinterpret_cast<const bf16x8*>(Qw + d0 * 16);
  const int sr = tid >> 4, sc = (tid & 15) * 8, vst0 = v_st(sr, sc), vst1 = v_st(32 + sr, sc);
  const int vb0 = (int)(uintptr_t)V_lds + v_rd_base(lane);
  const bf16_t* Kbase = proj + 512 + h * 128 + sc; const bf16_t* Vbase = proj + 1024 + h * 128 + sc;
  struct { bf16x8 vs0, vs1, ks0, ks1; } sr_[2];
#define KROW(k0) ((k0) < 256 ? crow0 + (k0) : lrow0 + (k0) - 256)
#define SLOAD(i, k0) do { const size_t _r0 = (size_t)(KROW(k0) + sr) * INC, _r1 = _r0 + (size_t)32 * INC; \
    sr_[i].vs0 = *reinterpret_cast<const bf16x8*>(Vbase + _r0); sr_[i].vs1 = *reinterpret_cast<const bf16x8*>(Vbase + _r1); \
    sr_[i].ks0 = *reinterpret_cast<const bf16x8*>(Kbase + _r0); sr_[i].ks1 = *reinterpret_cast<const bf16x8*>(Kbase + _r1); } while (0)
#define SWRITE(b, i) do { *(bf16x8*)(V_lds + (b) * SHM_V + vst0) = sr_[i].vs0;          \
    *(bf16x8*)(V_lds + (b) * SHM_V + vst1) = sr_[i].vs1; int kc = sc * 2;               \
    *(bf16x8*)(K_lds + (b) * SHM_K + KSWZ(sr, kc)) = sr_[i].ks0;                       \
    *(bf16x8*)(K_lds + (b) * SHM_K + KSWZ(32 + sr, kc)) = sr_[i].ks1; } while (0)
#define SWAIT() asm volatile("s_waitcnt vmcnt(4)" ::: "memory")
#define RESC(a) do { if (__any((a) < 1.f)) { \
    _Pragma("unroll") for (int d = 0; d < 4; ++d) _Pragma("unroll") for (int r = 0; r < 16; ++r) o[d][r] *= (a); } } while (0)
  f32x16 pA0, pA1, pB0, pB1; float mnA, mnB, alA, alB; bf16x8 pa0, pa1, pa2, pa3;
  constexpr int SE = 0, SO = 1;
  SLOAD(SE, 0); SLOAD(SO, KVBLK);
  SWRITE(0, SE); SLOAD(SE, 2 * KVBLK); __syncthreads();
  qkt(pA0, pA1, K_lds, qr, r32, hi, cmapB); partialSM(pA0, pA1, m_reg, mnA, alA);
  SWAIT(); SWRITE(1, SO); __syncthreads();
  for (int j = 1; j + 1 < NT; j += 2) {
    SBAR(); qk_fin(pB0, pB1, K_lds + SHM_K, qr, r32, hi, cmapB, pA0, pA1, alA, l_reg, pa0, pa1, pa2, pa3); SBAR();
    SLOAD(SO, (j + 2) * KVBLK); SBAR();
    pv_sm(o, vb0, pa0, pa1, pa2, pa3, pB0, pB1, m_reg, mnB, alB);
    __syncthreads(); SWAIT(); SWRITE(0, SE);
    RESC(alB); __syncthreads();
    SBAR(); qk_fin(pA0, pA1, K_lds, qr, r32, hi, cmapB, pB0, pB1, alB, l_reg, pa0, pa1, pa2, pa3); SBAR();
    SLOAD(SE, (j + 3 < NT ? j + 3 : NT - 1) * KVBLK); SBAR();
    pv_sm(o, vb0 + SHM_V, pa0, pa1, pa2, pa3, pA0, pA1, m_reg, mnA, alA);
    __syncthreads(); SWAIT(); SWRITE(1, SO);
    RESC(alA); __syncthreads();
  }
  SBAR(); qk_fin(pB0, pB1, K_lds + SHM_K, qr, r32, hi, cmapB, pA0, pA1, alA, l_reg, pa0, pa1, pa2, pa3); SBAR();
  pv_sm(o, vb0, pa0, pa1, pa2, pa3, pB0, pB1, m_reg, mnB, alB);
  __syncthreads(); RESC(alB);
  finishSM(pB0, pB1, alB, l_reg, pa0, pa1, pa2, pa3); SBAR();
  pv_d0(o, vb0 + SHM_V, pa0, pa1, pa2, pa3);
  const float rl = __builtin_amdgcn_rcpf(l_reg) * (cmap ? lam : 1.f);
  __syncthreads();
  float* OX = (float*)(lds + cmap * OX_BYTES) + (wq * 32 + r32) * OX_STRIDE + 4 * hi;
#pragma unroll
  for (int d0 = 0; d0 < 4; ++d0)
#pragma unroll
    for (int rg = 0; rg < 4; ++rg) { const f32x4 v = {o[d0][4 * rg + 0] * rl, o[d0][4 * rg + 1] * rl, o[d0][4 * rg + 2] * rl, o[d0][4 * rg + 3] * rl};
      *(f32x4*)(OX + d0 * 32 + 8 * rg) = v; }
  __syncthreads();
  { const int row = tid >> 2, q = tid & 3; const float* A = (const float*)lds + row * OX_STRIDE; const float* Bm = (const float*)(lds + OX_BYTES) + row * OX_STRIDE;
    f32x4 a[8]; float ss = 0.f;
#pragma unroll
    for (int i = 0; i < 8; ++i) { const int c4 = 4 * (q + 4 * i); a[i] = *(const f32x4*)(A + c4) - *(const f32x4*)(Bm + c4);
      ss += a[i][0] * a[i][0] + a[i][1] * a[i][1] + a[i][2] * a[i][2] + a[i][3] * a[i][3]; }
    ss += bperm_xor(ss, 1, lane); ss += bperm_xor(ss, 2, lane);
    const float rs = rsqrtf(ss * (1.f / 128.f) + EPS) * postscale;
    bf16_t* op = mix + (size_t)(qrow0 + row) * DM + h * 128;
#pragma unroll
    for (int i = 0; i < 8; ++i) { const int c4 = 4 * (q + 4 * i); const f32x4 g4 = *(const f32x4*)(gsub + c4); const f32x4 v = a[i] * g4 * rs;
      u32x2 w; w.x = cvt_pk_bf16(v[0], v[1]); w.y = cvt_pk_bf16(v[2], v[3]); *(u32x2*)(op + c4) = w; } }
  __syncthreads();
#undef KROW
#undef SLOAD
#undef SWRITE
#undef SWAIT
#undef RESC
}
}

__device__ __forceinline__ float bf2f(unsigned short b) { return __uint_as_float(((unsigned)b) << 16); }
__device__ __forceinline__ void unpack8(const bf16x8 v, float* f) {
#pragma unroll
  for (int j = 0; j < 8; ++j) f[j] = bf2f((unsigned short)v[j]);
}
__device__ __forceinline__ void mixer_item(const bf16_t* __restrict__ proj, bf16_t* __restrict__ mix, int rb, int p0, int Ls,
                                        const float* __restrict__ wconv, const bf16_t* __restrict__ wpoolT, const float* __restrict__ spool, char* lds) {
  const int tid = opaque_tid();
  constexpr int HS = 528;
  char* HT = lds;
  char* PT = lds + 80 * HS;
  bf16x8 hv[5];
#pragma unroll
  for (int k = 0; k < 5; ++k) { const int id = tid + k * NTHREADS; const int rr = id >> 5, ch = (id & 31) * 8; const int p = p0 - 8 + rr;
    hv[k] = (bf16x8){0, 0, 0, 0, 0, 0, 0, 0};
    if (id < 79 * 32 && p >= 0 && p < Ls) hv[k] = *reinterpret_cast<const bf16x8*>(proj + (size_t)(rb - 8 + rr) * INC + 2304 + ch); }
  bf16x8 rbg[4], ru0[4], rum[4], rup[4];
#pragma unroll
  for (int k = 0; k < 4; ++k) { const int id = tid + k * NTHREADS; const int tok = id >> 5, ch = (id & 31) * 8; const int p = p0 + tok;
    const bf16_t* rp = proj + (size_t)(rb + tok) * INC + 1536 + ch;
    const bf16_t* rm = (p > 0) ? rp - INC : rp; const bf16_t* rq = (p + 1 < Ls) ? rp + INC : rp;
    rbg[k] = *reinterpret_cast<const bf16x8*>(rp); ru0[k] = *reinterpret_cast<const bf16x8*>(rp + 256);
    rum[k] = *reinterpret_cast<const bf16x8*>(rm + 256); rup[k] = *reinterpret_cast<const bf16x8*>(rq + 256); }
#pragma unroll
  for (int k = 0; k < 5; ++k) { const int id = tid + k * NTHREADS; const int rr = id >> 5, ch = (id & 31) * 8;
    if (id < 79 * 32) *(bf16x8*)(HT + rr * HS + ch * 2) = hv[k]; }
#pragma unroll
  for (int k = 0; k < 4; ++k) { const int id = tid + k * NTHREADS; const int tok = id >> 5, ch = (id & 31) * 8; const int p = p0 + tok;
    float bg[8], um[8], u0[8], up[8], w0[8], w1[8], w2[8];
    unpack8(rbg[k], bg); unpack8(ru0[k], u0); unpack8(rum[k], um); unpack8(rup[k], up);
#pragma unroll
    for (int q = 0; q < 2; ++q) { const f32x4 a0 = *(const f32x4*)(wconv + ch + q * 4), a1 = *(const f32x4*)(wconv + 256 + ch + q * 4), a2 = *(const f32x4*)(wconv + 512 + ch + q * 4);
#pragma unroll
      for (int e = 0; e < 4; ++e) { w0[q * 4 + e] = a0[e]; w1[q * 4 + e] = a1[e]; w2[q * 4 + e] = a2[e]; } }
    const float fm = (p > 0) ? 1.f : 0.f, fp = (p + 1 < Ls) ? 1.f : 0.f;
    float y[8];
#pragma unroll
    for (int j = 0; j < 8; ++j) y[j] = bg[j] * (fm * um[j] * w0[j] + u0[j] * w1[j] + fp * up[j] * w2[j]);
    u32x4 w; w.x = cvt_pk_bf16(y[0], y[1]); w.y = cvt_pk_bf16(y[2], y[3]); w.z = cvt_pk_bf16(y[4], y[5]); w.w = cvt_pk_bf16(y[6], y[7]);
    *(u32x4*)(mix + (size_t)(rb + tok) * DM + 512 + ch) = w; }
  __syncthreads();
#pragma unroll
  for (int g = 0; g < 4; ++g) { const int hw = 1 << g; const int tok = tid >> 3, c0 = g * 64 + (tid & 7) * 8, colb = c0 * 2; const int p = p0 + tok;
    float sm[8] = {0.f, 0.f, 0.f, 0.f, 0.f, 0.f, 0.f, 0.f};
#pragma unroll
    for (int q = -hw; q < hw; ++q) { float f[8]; unpack8(*(const bf16x8*)(HT + (tok + 8 + q) * HS + colb), f);
#pragma unroll
      for (int j = 0; j < 8; ++j) sm[j] += f[j]; }
    int lo = p - hw, hi2 = p + hw - 1; if (lo < 0) lo = 0; if (hi2 > Ls - 1) hi2 = Ls - 1;
    float self[8]; unpack8(*(const bf16x8*)(HT + (tok + 8) * HS + colb), self);
    const float inv = 1.f / (float)(hi2 - lo + 1);
    const f32x4 s0 = *(const f32x4*)(spool + c0), s1 = *(const f32x4*)(spool + c0 + 4);
    float y[8];
#pragma unroll
    for (int j = 0; j < 4; ++j) { y[j] = (sm[j] * inv - self[j]) * s0[j]; y[4 + j] = (sm[4 + j] * inv - self[4 + j]) * s1[j]; }
    u32x4 w; w.x = cvt_pk_bf16(y[0], y[1]); w.y = cvt_pk_bf16(y[2], y[3]); w.z = cvt_pk_bf16(y[4], y[5]); w.w = cvt_pk_bf16(y[6], y[7]);
    *(u32x4*)(mix + (size_t)(rb + tok) * DM + 768 + c0) = w; }
  __syncthreads();
}

__device__ __forceinline__ float wave_sum(float v, int lane) {
#pragma unroll
  for (int o = 32; o >= 1; o >>= 1) v += bperm_xor(v, o, lane);
  return v;
}
__device__ __forceinline__ void unpack_bf8(const u32x4 w, float* f) {
  f[0] = __uint_as_float(w.x << 16); f[1] = __uint_as_float(w.x & 0xffff0000u); f[2] = __uint_as_float(w.y << 16); f[3] = __uint_as_float(w.y & 0xffff0000u);
  f[4] = __uint_as_float(w.z << 16); f[5] = __uint_as_float(w.z & 0xffff0000u); f[6] = __uint_as_float(w.w << 16); f[7] = __uint_as_float(w.w & 0xffff0000u);
}
__device__ __forceinline__ u32x4 pack_bf8(const float* f) { u32x4 w; w.x = cvt_pk_bf16(f[0], f[1]); w.y = cvt_pk_bf16(f[2], f[3]); w.z = cvt_pk_bf16(f[4], f[5]); w.w = cvt_pk_bf16(f[6], f[7]); return w; }
template <bool F32SRC>
__device__ __forceinline__ void norm_phase(const float* xlat, const float* xctx, bf16_t* xb, const float* g, const float* modl, int shi, int sci, bf16_t* act, int nrows) {
  constexpr int NRW = F32SRC ? 4 : 8;
  const int tid = opaque_tid(); const int lane = tid & 63; const int gw = blockIdx.x * 8 + (tid >> 6), nw = gridDim.x * 8;
  const int rpw = (nrows + nw - 1) / nw; const int r0 = gw * rpw; const int r1 = (r0 + rpw < nrows) ? r0 + rpw : nrows;
  float gg[16], scv[16], shv[16];
#pragma unroll
  for (int i = 0; i < 2; ++i)
#pragma unroll
    for (int q = 0; q < 2; ++q) { const f32x4 t = *(const f32x4*)(g + i * 512 + lane * 8 + q * 4); gg[i * 8 + q * 4 + 0] = t[0]; gg[i * 8 + q * 4 + 1] = t[1]; gg[i * 8 + q * 4 + 2] = t[2]; gg[i * 8 + q * 4 + 3] = t[3]; }
#pragma unroll
  for (int k = 0; k < 16; ++k) { scv[k] = 0.f; shv[k] = 0.f; }
  int bcur = -1;
#pragma unroll 1
  for (int rb = r0; rb < r1; rb += NRW) {
    u32x4 raw[NRW][2]; f32x4 rawf[F32SRC ? NRW : 1][4];
#pragma unroll
    for (int j = 0; j < NRW; ++j) { const int r = rb + j;
      if (F32SRC) {
#pragma unroll
        for (int i = 0; i < 4; ++i) rawf[F32SRC ? j : 0][i] = (f32x4){0.f, 0.f, 0.f, 0.f};
        if (r < r1) { const float* src = (r < MLAT) ? xlat + (size_t)r * DM : xctx + (size_t)(r - MLAT) * DM;
#pragma unroll
          for (int i = 0; i < 4; ++i) rawf[F32SRC ? j : 0][i] = *(const f32x4*)(src + (i >> 1) * 512 + lane * 8 + (i & 1) * 4); }
      } else {
        raw[j][0] = (u32x4){0u, 0u, 0u, 0u}; raw[j][1] = raw[j][0];
        if (r < r1) { raw[j][0] = *(const u32x4*)(xb + (size_t)r * DM + lane * 8); raw[j][1] = *(const u32x4*)(xb + (size_t)r * DM + 512 + lane * 8); } } }
#pragma unroll
    for (int j = 0; j < NRW; ++j) { const int r = rb + j; float v[16];
      if (F32SRC) {
#pragma unroll
        for (int i = 0; i < 4; ++i) { const f32x4 t = rawf[F32SRC ? j : 0][i]; v[i * 4 + 0] = t[0]; v[i * 4 + 1] = t[1]; v[i * 4 + 2] = t[2]; v[i * 4 + 3] = t[3]; }
      } else { unpack_bf8(raw[j][0], v); unpack_bf8(raw[j][1], v + 8); }
      float ss = 0.f;
#pragma unroll
      for (int k = 0; k < 16; ++k) ss += v[k] * v[k];
      const float rs = rsqrtf(wave_sum(ss, lane) * (1.f / DM) + EPS);
      if (r < r1) { const int b = (r < MLAT) ? (r >> 11) : 32;
        if (b != bcur) { bcur = b; const float* mb = modl + (size_t)b * (NMOD * DM);
#pragma unroll
          for (int i = 0; i < 2; ++i)
#pragma unroll
            for (int q = 0; q < 2; ++q) { const f32x4 t = *(const f32x4*)(mb + sci * DM + i * 512 + lane * 8 + q * 4), u = *(const f32x4*)(mb + shi * DM + i * 512 + lane * 8 + q * 4);
#pragma unroll
              for (int e = 0; e < 4; ++e) { scv[i * 8 + q * 4 + e] = t[e] + 1.f; shv[i * 8 + q * 4 + e] = u[e]; } } }
        if (F32SRC) { *(u32x4*)(xb + (size_t)r * DM + lane * 8) = pack_bf8(v); *(u32x4*)(xb + (size_t)r * DM + 512 + lane * 8) = pack_bf8(v + 8); }
        float y[16];
#pragma unroll
        for (int k = 0; k < 16; ++k) y[k] = (v[k] * rs) * gg[k] * scv[k] + shv[k];
        *(u32x4*)(act + (size_t)r * DM + lane * 8) = pack_bf8(y); *(u32x4*)(act + (size_t)r * DM + 512 + lane * 8) = pack_bf8(y + 8); } }
  }
}
__device__ __forceinline__ void final_norm(const bf16_t* xb, float* out, const float* g) {
  constexpr int NRW = 8;
  const int tid = opaque_tid(); const int lane = tid & 63; const int gw = blockIdx.x * 8 + (tid >> 6), nw = gridDim.x * 8;
  const int rpw = (MLAT + nw - 1) / nw; const int r0 = gw * rpw; const int r1 = (r0 + rpw < MLAT) ? r0 + rpw : MLAT;
  float gg[16];
#pragma unroll
  for (int i = 0; i < 2; ++i)
#pragma unroll
    for (int q = 0; q < 2; ++q) { const f32x4 t = *(const f32x4*)(g + i * 512 + lane * 8 + q * 4); gg[i * 8 + q * 4 + 0] = t[0]; gg[i * 8 + q * 4 + 1] = t[1]; gg[i * 8 + q * 4 + 2] = t[2]; gg[i * 8 + q * 4 + 3] = t[3]; }
#pragma unroll 1
  for (int rb = r0; rb < r1; rb += NRW) {
    u32x4 raw[NRW][2];
#pragma unroll
    for (int j = 0; j < NRW; ++j) { const int r = rb + j; raw[j][0] = (u32x4){0u, 0u, 0u, 0u}; raw[j][1] = raw[j][0];
      if (r < r1) { raw[j][0] = *(const u32x4*)(xb + (size_t)r * DM + lane * 8); raw[j][1] = *(const u32x4*)(xb + (size_t)r * DM + 512 + lane * 8); } }
#pragma unroll
    for (int j = 0; j < NRW; ++j) { const int r = rb + j; float v[16]; unpack_bf8(raw[j][0], v); unpack_bf8(raw[j][1], v + 8);
      float ss = 0.f;
#pragma unroll
      for (int k = 0; k < 16; ++k) ss += v[k] * v[k];
      const float rs = rsqrtf(wave_sum(ss, lane) * (1.f / DM) + EPS);
      if (r < r1) {
#pragma unroll
        for (int i = 0; i < 2; ++i)
#pragma unroll
          for (int q = 0; q < 2; ++q) { f32x4 o; o[0] = v[i * 8 + q * 4 + 0] * rs * gg[i * 8 + q * 4 + 0]; o[1] = v[i * 8 + q * 4 + 1] * rs * gg[i * 8 + q * 4 + 1];
            o[2] = v[i * 8 + q * 4 + 2] * rs * gg[i * 8 + q * 4 + 2]; o[3] = v[i * 8 + q * 4 + 3] * rs * gg[i * 8 + q * 4 + 3];
            *(f32x4*)(out + (size_t)r * DM + i * 512 + lane * 8 + q * 4) = o; } } }
  }
}
__device__ __forceinline__ void transpose_tile(const float* src, int ldS, bf16_t* dst, int ldD, int k0, int n0s, int n0d, float* tile) {
  const int tid = opaque_tid();
  { const int i = tid >> 3, j0 = (tid & 7) * 8; const float* p = src + (size_t)(k0 + i) * ldS + n0s + j0;
    const f32x4 a = *(const f32x4*)p, b = *(const f32x4*)(p + 4); float* t = tile + i * 65 + j0;
    t[0] = a[0]; t[1] = a[1]; t[2] = a[2]; t[3] = a[3]; t[4] = b[0]; t[5] = b[1]; t[6] = b[2]; t[7] = b[3]; }
  __syncthreads();
  { const int n = tid >> 3, kk0 = (tid & 7) * 8; float v[8];
#pragma unroll
    for (int j = 0; j < 8; ++j) v[j] = tile[(kk0 + j) * 65 + n];
    u32x4 w; w.x = cvt_pk_bf16(v[0], v[1]); w.y = cvt_pk_bf16(v[2], v[3]); w.z = cvt_pk_bf16(v[4], v[5]); w.w = cvt_pk_bf16(v[6], v[7]);
    *(u32x4*)(dst + (size_t)(n0d + n) * ldD + k0 + kk0) = w; }
  __syncthreads();
}
__device__ __forceinline__ void mod_item(const float* c, const float* cctx, const float* wada_l, const float* bada_l, float* mod_l, int n0, float* lds) {
  const int tid = opaque_tid();
  for (int i = tid; i < 33 * DM; i += NTHREADS) { const float v = (i < 32 * DM) ? c[i] : cctx[i - 32 * DM]; lds[i] = v / (1.f + __expf(-v)); }
  __syncthreads();
  const int col = tid & 127, kq = tid >> 7;
  float acc[33];
#pragma unroll
  for (int b = 0; b < 33; ++b) acc[b] = 0.f;
  const float* wp = wada_l + (size_t)(kq * 256) * (NMOD * DM) + n0 + col;
#pragma unroll 1
  for (int k = 0; k < 256; k += 8) {
    float w[8];
#pragma unroll
    for (int i = 0; i < 8; ++i) w[i] = wp[(size_t)(k + i) * (NMOD * DM)];
#pragma unroll
    for (int b = 0; b < 33; ++b) { const f32x4 s = *(const f32x4*)(lds + b * DM + kq * 256 + k), t = *(const f32x4*)(lds + b * DM + kq * 256 + k + 4);
      acc[b] += s[0] * w[0] + s[1] * w[1] + s[2] * w[2] + s[3] * w[3] + t[0] * w[4] + t[1] * w[5] + t[2] * w[6] + t[3] * w[7]; }
  }
  __syncthreads();
#pragma unroll
  for (int b = 0; b < 33; ++b) lds[(kq * 33 + b) * 128 + col] = acc[b];
  __syncthreads();
  for (int o = tid; o < 33 * 128; o += NTHREADS) { const int b = o >> 7, cc = o & 127;
    mod_l[(size_t)b * (NMOD * DM) + n0 + cc] = lds[(0 * 33 + b) * 128 + cc] + lds[(1 * 33 + b) * 128 + cc] + lds[(2 * 33 + b) * 128 + cc] + lds[(3 * 33 + b) * 128 + cc] + bada_l[n0 + cc]; }
  __syncthreads();
}

__device__ __forceinline__ void grid_bar(unsigned* ctr, unsigned target) {
  __syncthreads();
  if (threadIdx.x == 0) {
    __builtin_amdgcn_fence(__ATOMIC_RELEASE, "agent");
    asm volatile("s_waitcnt vmcnt(0)" ::: "memory");
    __hip_atomic_fetch_add(ctr, 1u, __ATOMIC_RELAXED, __HIP_MEMORY_SCOPE_AGENT);
    while (__hip_atomic_load(ctr, __ATOMIC_RELAXED, __HIP_MEMORY_SCOPE_AGENT) < target) __builtin_amdgcn_s_sleep(2);
    __builtin_amdgcn_fence(__ATOMIC_ACQUIRE, "agent");
    asm volatile("s_waitcnt vmcnt(0)" ::: "memory");
  }
  __syncthreads();
}
__global__ void __launch_bounds__(NTHREADS, 2) fwd_megakernel(Params P) {
  extern __shared__ __attribute__((aligned(16))) unsigned char lds[];
  cg::grid_group grid = cg::this_grid();
  const int tid = threadIdx.x, G = gridDim.x, bid = blockIdx.x;
  unsigned char* ws = P.ws;
  bf16_t* H2 = (bf16_t*)(ws + WS_H2); float* XCH = (float*)(ws + WS_XCH); unsigned* CNT = (unsigned*)(ws + WS_CNT);
  bf16_t* XB = (bf16_t*)(ws + WS_XB); bf16_t* ACT = (bf16_t*)(ws + WS_ACT); bf16_t* PROJ = (bf16_t*)(ws + WS_PROJ);
  bf16_t* WB = (bf16_t*)(ws + WS_W); bf16_t* WPOOL = (bf16_t*)(ws + WS_WPOOL); float* MOD = (float*)(ws + WS_MOD);
  float* ROPE = (float*)(ws + WS_ROPE); float* LAMV = (float*)(ws + WS_LAM);
  const float* x_in = P.in[0]; const float* ctx_in = P.in[2];

  for (int rep = 0; rep < ((DUP & 8) ? 2 : 1); ++rep)
  if constexpr (EN(0)) {
    constexpr int TILES_L = 640 + 256 + 1408 + 704 + 4;
    const int nItems = 192 + DEPTH * TILES_L + 1;
    for (int it = bid; it < nItems; it += G) {
      if (it < 192) { const int l = it / 48, nb = it % 48;
        mod_item(P.in[1], P.in[3], P.in[4] + (size_t)l * DM * NMOD * DM, P.in[5] + (size_t)l * NMOD * DM, MOD + (size_t)l * 33 * NMOD * DM, nb * 128, (float*)lds);
      } else if (it < 192 + DEPTH * TILES_L) {
        const int t = it - 192; const int l = t / TILES_L; int r = t % TILES_L; bf16_t* wl = WB + (size_t)l * W_LAYER_E; float* tile = (float*)lds;
        if (r < 640 && (r % 40) >= 36) {
          const int g = (r % 40) - 36, k0 = (r / 40) * 64; const int i = tid >> 3, j0 = (tid & 7) * 8; float* At = tile; float* Wt = tile + 64 * 65;
          { const float* pa = P.in[7] + (size_t)l * DM * INC + (size_t)(k0 + i) * INC + 2304 + g * 64 + j0; const float* pw = P.in[14] + (size_t)(l * 4 + g) * 4096 + i * 64 + j0;
            const f32x4 a0 = *(const f32x4*)pa, a1 = *(const f32x4*)(pa + 4), w0 = *(const f32x4*)pw, w1 = *(const f32x4*)(pw + 4);
#pragma unroll
            for (int e = 0; e < 4; ++e) { At[i * 65 + j0 + e] = a0[e]; At[i * 65 + j0 + 4 + e] = a1[e]; Wt[i * 64 + j0 + e] = w0[e]; Wt[i * 64 + j0 + 4 + e] = w1[e]; } }
          __syncthreads();
          float o[8] = {0.f, 0.f, 0.f, 0.f, 0.f, 0.f, 0.f, 0.f};
          for (int c = 0; c < 64; ++c) { const float a = At[i * 65 + c]; const f32x4 w0 = *(const f32x4*)(Wt + c * 64 + j0), w1 = *(const f32x4*)(Wt + c * 64 + j0 + 4);
#pragma unroll
            for (int e = 0; e < 4; ++e) { o[e] += a * w0[e]; o[4 + e] += a * w1[e]; } }
          __syncthreads();
#pragma unroll
          for (int e = 0; e < 8; ++e) At[i * 65 + j0 + e] = o[e];
          __syncthreads();
          { const int n = tid >> 3, kk0 = (tid & 7) * 8; float v[8];
#pragma unroll
            for (int j = 0; j < 8; ++j) v[j] = At[(kk0 + j) * 65 + n];
            u32x4 w; w.x = cvt_pk_bf16(v[0], v[1]); w.y = cvt_pk_bf16(v[2], v[3]); w.z = cvt_pk_bf16(v[4], v[5]); w.w = cvt_pk_bf16(v[6], v[7]);
            *(u32x4*)(wl + (size_t)(2304 + g * 64 + n) * DM + k0 + kk0) = w; }
          __syncthreads();
        } else if (r < 640) { const int n0 = (r % 40) * 64; int nd = n0;
          if (n0 >= 1792 && n0 < 2304) { const int xin = n0 >= 2048; const int c = n0 - (xin ? 2048 : 1792); nd = 1792 + (c / 128) * 256 + (xin ? 128 : 0) + (c % 128); }
          transpose_tile(P.in[7] + (size_t)l * DM * INC, INC, wl, DM, (r / 40) * 64, n0, nd, tile); }
        else if ((r -= 640) < 256) { transpose_tile(P.in[16] + (size_t)l * DM * DM, DM, wl + W_IN_E, DM, (r / 16) * 64, (r % 16) * 64, (r % 16) * 64, tile); }
        else if ((r -= 256) < 1408) { const int n0 = (r % 88) * 64; const int up = n0 >= FFN; const int j0 = up ? n0 - FFN : n0; const int nd = 256 * (j0 / 128) + (up ? 128 : 0) + (j0 % 128);
          transpose_tile(P.in[18] + (size_t)l * DM * 2 * FFN, 2 * FFN, wl + W_IN_E + W_OUT_E, DM, (r / 88) * 64, n0, nd, tile); }
        else if ((r -= 1408) < 704) { transpose_tile(P.in[19] + (size_t)l * FFN * DM, DM, wl + W_IN_E + W_OUT_E + W_GU_E, FFN, (r / 16) * 64, (r % 16) * 64, (r % 16) * 64, tile); }
        else { r -= 704; transpose_tile(P.in[14] + (size_t)(l * 4 + r) * 4096, 64, WPOOL + (size_t)(l * 4 + r) * 4096, 64, 0, 0, 0, tile); }
      } else {
        for (int i = tid; i < 64 * 16; i += NTHREADS) { const int pos = i >> 4, f = i & 15; const float inv = 1.0f / powf(10000.0f, (float)f / 16.0f); const float ang = (float)pos * inv;
          ROPE[i] = cosf(ang); ROPE[1024 + i] = sinf(ang); }
        if (tid < DEPTH) { const int l = tid; float d1 = 0.f, d2 = 0.f;
          for (int i = 0; i < 64; ++i) { d1 += P.in[8][l * 64 + i] * P.in[9][l * 64 + i]; d2 += P.in[10][l * 64 + i] * P.in[11][l * 64 + i]; }
          const float li = 0.8f - 0.6f * expf(-0.3f * (float)l);
          LAMV[l * 2] = expf(d1) - expf(d2) + li; LAMV[l * 2 + 1] = 1.f - li; }
      }
    }
  }
  for (int i = bid * NTHREADS + tid; i < NFUSE * MALL; i += G * NTHREADS) { const f32x4 m1 = {-1.f, -1.f, -1.f, -1.f}; f32x4* sp = (f32x4*)XCH + i;
    asm volatile("global_store_dwordx4 %0, %1, off sc1" :: "v"(sp), "v"(m1) : "memory"); }
  for (int i = bid * NTHREADS + tid; i < 2 * DM; i += G * NTHREADS) ((float*)CNT)[i] = 0.f;
  const bool fuse_ok = (G == 256);
  unsigned* BARC = (unsigned*)(ws + WS_BAR); unsigned nbar = 0;
  if (bid == 0 && tid == 0) __hip_atomic_store(BARC, 0u, __ATOMIC_RELAXED, __HIP_MEMORY_SCOPE_AGENT);
  grid.sync();

  for (int l = 0; l < DEPTH; ++l) {
    const bool last = (l == DEPTH - 1);
    const float* modl = MOD + (size_t)l * 33 * NMOD * DM;
    const bf16_t* wl = WB + (size_t)l * W_LAYER_E;
    if (l == 0) { norm_phase<true>(x_in, ctx_in, XB, P.in[6] + l * DM, modl, 0, 1, ACT, MALL); grid_bar(BARC, (unsigned)G * (++nbar)); }
    else if (!fuse_ok) { norm_phase<false>(nullptr, nullptr, XB, P.in[6] + l * DM, modl, 0, 1, ACT, MALL); grid_bar(BARC, (unsigned)G * (++nbar)); }
    for (int rep = 0; rep < ((DUP & 2) ? 2 : 1); ++rep)
    if constexpr (EN(2)) { pg8::Gemm g{ACT, wl, DM}; pg8::Sched S; S.init(INC / 256, MCTX / 256, last ? 2 : 0, last ? 4 : INC / 256, G, bid);
      pg8::EpiProj E{PROJ, ROPE, ROPE + 1024};
      pg8::gemm_phase<pg8::EpiProj>((LAS unsigned char*)lds, g, S, E); }
    grid_bar(BARC, (unsigned)G * (++nbar));
    for (int rep = 0; rep < ((DUP & 1) ? 2 : 1); ++rep)
    if constexpr (EN(3)) { const float lam = LAMV[l * 2], post = LAMV[l * 2 + 1]; const float* gsub = P.in[12] + l * 128;
      const int nAttL = NB * 4 * 16, nAttC = last ? 0 : NB * 4 * 2, nMix = last ? MLAT / 64 : MALL / 64;
      const int nItems = nAttL + nAttC + nMix;
      for (int it = bid; it < nItems; it += G) {
        if (it < nAttL + nAttC) { int bh, qb, qrow0, lrow0, NT;
          if (it < nAttL) {
            if (G == 256) { const int j = it & 255, k = it >> 8, xcd = j & 7, slot = j >> 3; bh = k * 16 + xcd * 2 + (slot >> 4); qb = slot & 15; } else { bh = it >> 4; qb = it & 15; }
            qrow0 = (bh >> 2) * SEQ + qb * 128; lrow0 = (bh >> 2) * SEQ; NT = 36;
          } else { const int id = it - nAttL; bh = id >> 1; qb = id & 1; qrow0 = MLAT + (bh >> 2) * CTXL + qb * 128; lrow0 = 0; NT = 4; }
          att::attn_item(PROJ, ACT, qrow0, bh & 3, MLAT + (bh >> 2) * CTXL, lrow0, NT, lam, post, gsub, (char*)lds);
        } else { const int tile = it - nAttL - nAttC; int rb, p0, Ls;
          if (tile < MLAT / 64) { rb = tile * 64; p0 = (tile & 31) * 64; Ls = SEQ; } else { rb = tile * 64; p0 = (tile & 3) * 64; Ls = CTXL; }
          for (int rep2 = 0; rep2 < ((DUP & 32) ? 2 : 1); ++rep2)
          mixer_item(PROJ, ACT, rb, p0, Ls, P.in[13] + l * 768, WPOOL + (size_t)l * 4 * 4096, P.in[15] + l * 256, (char*)lds);
        }
      }
    }
    grid_bar(BARC, (unsigned)G * (++nbar));
    if constexpr (EN(4)) { pg8::Gemm g{ACT, wl + W_IN_E, DM}; pg8::Sched S; S.init(DM / 256, last ? 0 : MCTX / 256, 0, DM / 256, G, bid);
      pg8::EpiResNorm E{XB, modl + 2 * DM, fuse_ok, H2, P.in[17] + l * DM, modl, 3, 4, XCH + (size_t)(2 * l) * MALL * 4, (LAS unsigned char*)lds + pg8::STAGE_BYTES, nullptr, NMOD * DM};
      pg8::gemm_phase<pg8::EpiResNorm>((LAS unsigned char*)lds, g, S, E); }
    grid_bar(BARC, (unsigned)G * (++nbar));
    if (!fuse_ok) { norm_phase<false>(nullptr, nullptr, XB, P.in[17] + l * DM, modl, 3, 4, H2, last ? MLAT : MALL); grid_bar(BARC, (unsigned)G * (++nbar)); }
    for (int rep = 0; rep < ((DUP & 2) ? 2 : 1); ++rep)
    if constexpr (EN(6)) { pg8::Gemm g{H2, wl + W_IN_E + W_OUT_E, DM}; pg8::Sched S; S.init(2 * FFN / 256, last ? 0 : MCTX / 256, 0, 2 * FFN / 256, G, bid);
      pg8::EpiSwi E{PROJ};
      pg8::gemm_phase<pg8::EpiSwi>((LAS unsigned char*)lds, g, S, E); }
    grid_bar(BARC, (unsigned)G * (++nbar));
    if constexpr (EN(7)) { pg8::Gemm g{PROJ, wl + W_IN_E + W_OUT_E + W_GU_E, FFN}; pg8::Sched S; S.init(DM / 256, last ? 0 : MCTX / 256, 0, DM / 256, G, bid);
      const int ln = last ? l : l + 1;
      const bool fin = last && fuse_ok;
      pg8::EpiResNorm E{XB, modl + 5 * DM, fuse_ok, ACT, fin ? P.in[20] : P.in[6] + ln * DM, fin ? (const float*)CNT : MOD + (size_t)ln * 33 * NMOD * DM, 0, 1, XCH + (size_t)(2 * l + 1) * MALL * 4, (LAS unsigned char*)lds + pg8::STAGE_BYTES, fin ? P.out : nullptr, fin ? 0 : NMOD * DM};
      pg8::gemm_phase<pg8::EpiResNorm>((LAS unsigned char*)lds, g, S, E); }
    grid_bar(BARC, (unsigned)G * (++nbar));
  }
  if (!fuse_ok) final_norm(XB, P.out, P.in[20]);
}

extern "C" void kernel_launch(void* const* d_in, const int* in_sizes, int n_in, void* d_out, int out_size, void* d_ws, size_t ws_size, hipStream_t stream) {
  static int grid_blocks = 0;
  if (grid_blocks == 0) {
    if (n_in != 21 || out_size != MLAT * DM || ws_size < WS_END) { fprintf(stderr, "kernel_launch: unexpected shapes n_in %d out %d ws %zu (need %zu)\n", n_in, out_size, ws_size, (size_t)WS_END); grid_blocks = -1; return; }
    int dev = 0, cus = 0, per_cu = 0;
    hipGetDevice(&dev); hipDeviceGetAttribute(&cus, hipDeviceAttributeMultiprocessorCount, dev);
    if (hipFuncSetAttribute((const void*)fwd_megakernel, hipFuncAttributeMaxDynamicSharedMemorySize, LDS_BYTES) != hipSuccess) { fprintf(stderr, "kernel_launch: hipFuncSetAttribute failed\n"); grid_blocks = -1; return; }
    hipOccupancyMaxActiveBlocksPerMultiprocessor(&per_cu, (const void*)fwd_megakernel, NTHREADS, LDS_BYTES);
    if (per_cu < 1) { fprintf(stderr, "kernel_launch: occupancy query says %d blocks per CU\n", per_cu); per_cu = 1; }
    grid_blocks = cus * 1;
    (void)hipGetLastError();
  }
  if (grid_blocks < 0) return;
  Params p{};
  for (int i = 0; i < 21; ++i) p.in[i] = (const float*)d_in[i];
  p.out = (float*)d_out; p.ws = (unsigned char*)d_ws;
  void* args[] = {&p};
  hipError_t e = hipLaunchCooperativeKernel((const void*)fwd_megakernel, dim3(grid_blocks), dim3(NTHREADS), args, LDS_BYTES, stream);
  if (e != hipSuccess) fprintf(stderr, "cooperative launch failed: %s (grid %d)\n", hipGetErrorString(e), grid_blocks);
}
```
